# Optimizing an MI355X kernel written in HIP

```python
import math
import jax
import jax.numpy as jnp
from jax import lax
import numpy as np

D_MODEL = 1024
BATCH = 32
SEQ = 256
DEPTH = 2
DEC_BATCH = 8
DEC_SEQ = 1024
PAST_LEN = 256

GRID_W = 64
ROPE_BASE = 10000.0
RMS_EPS = 1e-6
Q_BLOCK = 128

H_A = 8
QK_NOPE = 64
QK_ROPE = 32
V_HD_A = 64
Q_LORA = 256
KV_LORA = 128
H_B = 4
DIFF_HD = 64
DIFF_VD = 2 * DIFF_HD
H_C = 8
DK_C = 64
DV_C = D_MODEL // H_C
MLSTM_CHUNK = 64
I_BIAS_INIT = -2.0
F_BIAS_INIT = 3.0
D_FF = -(-8 * D_MODEL // (3 * 256)) * 256

IN_AB = Q_LORA + KV_LORA + QK_ROPE + 3 * H_B * 2 * DIFF_HD
OUT_AB = H_A * V_HD_A + H_B * DIFF_VD
IN_C = 2 * H_C * DK_C + 2 * H_C * DV_C + 4 * H_C
N_EVEN = (DEPTH + 1) // 2
N_ODD = DEPTH // 2

kernel_name = 'hybrid_mla_diff_mlstm_dit_step'


def rms_norm(x, g):
    xf = x.astype(jnp.float32)
    y = xf * lax.rsqrt(jnp.mean(xf * xf, axis=-1, keepdims=True) + RMS_EPS)
    return (y * g.astype(jnp.float32)).astype(x.dtype)


def rope1d(x, pos):
    half = x.shape[-1] // 2
    freqs = jnp.power(ROPE_BASE, -jnp.arange(half, dtype=jnp.float32) / half)
    ang = pos[:, None] * freqs[None, :]
    cos = jnp.cos(ang).astype(x.dtype)
    sin = jnp.sin(ang).astype(x.dtype)
    x1, x2 = x[..., :half], x[..., half:]
    return jnp.concatenate([x1 * cos - x2 * sin, x1 * sin + x2 * cos], axis=-1)


def rope2d(x, rows, cols):
    h = x.shape[-1] // 2
    return jnp.concatenate([rope1d(x[..., :h], rows), rope1d(x[..., h:], cols)], axis=-1)


def rope2d_pair(x, rows, cols):
    return jnp.concatenate([rope2d(x[..., :DIFF_HD], rows, cols), rope2d(x[..., DIFF_HD:], rows, cols)], axis=-1)


def grid_positions(n_tok):
    n_rows = n_tok // GRID_W
    t = jnp.arange(n_rows * GRID_W)
    return (t // GRID_W).astype(jnp.float32), (t % GRID_W).astype(jnp.float32)


def softmax_probs(q, k, scale):
    s = jnp.einsum('bhqd,bhkd->bhqk', q, k).astype(jnp.float32) * scale
    return jax.nn.softmax(s, axis=-1)


def map_query_blocks(fn, *qs):
    B, H, T, _ = qs[0].shape
    nb = T // Q_BLOCK
    blocks = tuple(q.reshape(B, H, nb, Q_BLOCK, q.shape[-1]).transpose(2, 0, 1, 3, 4) for q in qs)
    out = lax.map(lambda qb: fn(*qb), blocks)
    return out.transpose(1, 2, 0, 3, 4).reshape(B, H, T, out.shape[-1])


def adaln(cond, w, b):
    return jnp.split((jax.nn.silu(cond) @ w + b)[:, None, :], 6, axis=-1)


def modulate(x, g, shift, scale):
    return rms_norm(x, g) * (1.0 + scale) + shift


def swiglu(h, w_in, w_out):
    a, b = jnp.split(h @ w_in, 2, axis=-1)
    return (jax.nn.silu(a) * b) @ w_out


def even_mixer(h, w_in, g_ql, g_kvl, w_uq, w_ukv, lam_vec, g_sub, w_out, lam_init, pos=None, ctx=None):
    B, T, _ = h.shape
    c0 = Q_LORA
    c1 = c0 + KV_LORA
    c2 = c1 + QK_ROPE
    c3 = c2 + H_B * 2 * DIFF_HD
    c4 = c3 + H_B * 2 * DIFF_HD
    cq, ckv, kr, dq, dk, dv = jnp.split(h @ w_in, [c0, c1, c2, c3, c4], axis=-1)
    ckv = rms_norm(ckv, g_kvl)
    qa = (rms_norm(cq, g_ql) @ w_uq).reshape(B, T, H_A, QK_NOPE + QK_ROPE).transpose(0, 2, 1, 3)
    q_nope, q_rope = qa[..., :QK_NOPE], qa[..., QK_NOPE:]
    dq = dq.reshape(B, T, H_B, 2 * DIFF_HD).transpose(0, 2, 1, 3)
    dk = dk.reshape(B, T, H_B, 2 * DIFF_HD).transpose(0, 2, 1, 3)
    dv = dv.reshape(B, T, H_B, DIFF_VD).transpose(0, 2, 1, 3)
    own = (ckv, kr, dk, dv)
    if pos is None:
        ckv_all, kr_all, dk_all, dv_all = own
    else:
        rows, cols = pos
        q_rope = rope2d(q_rope, rows, cols)
        dq = rope2d_pair(dq, rows, cols)
        ckv_c, kr_c, dk_c, dv_c = ctx
        ckv_all = jnp.concatenate([ckv, ckv_c], axis=1)
        kr_all = jnp.concatenate([rope2d(kr, rows, cols), kr_c], axis=1)
        dk_all = jnp.concatenate([rope2d_pair(dk, rows, cols), dk_c], axis=2)
        dv_all = jnp.concatenate([dv, dv_c], axis=2)
    K = ckv_all.shape[1]
    kv = (ckv_all @ w_ukv).reshape(B, K, H_A, QK_NOPE + V_HD_A).transpose(0, 2, 1, 3)
    k_a = jnp.concatenate([kv[..., :QK_NOPE], jnp.broadcast_to(kr_all[:, None], (B, H_A, K, QK_ROPE))], axis=-1)
    v_a = kv[..., QK_NOPE:]
    q_a = jnp.concatenate([q_nope, q_rope], axis=-1)
    scale_a = (QK_NOPE + QK_ROPE) ** -0.5

    def mla_block(qb):
        p = softmax_probs(qb, k_a, scale_a)
        return jnp.einsum('bhqk,bhkd->bhqd', p.astype(v_a.dtype), v_a)

    out_a = map_query_blocks(mla_block, q_a)
    lv = lam_vec.astype(jnp.float32)
    lam = jnp.exp(jnp.sum(lv[0] * lv[1])) - jnp.exp(jnp.sum(lv[2] * lv[3])) + lam_init
    k1, k2 = dk_all[..., :DIFF_HD], dk_all[..., DIFF_HD:]
    scale_b = DIFF_HD ** -0.5

    def diff_block(q1, q2):
        p = softmax_probs(q1, k1, scale_b) - lam * softmax_probs(q2, k2, scale_b)
        return jnp.einsum('bhqk,bhkd->bhqd', p.astype(dv_all.dtype), dv_all)

    out_b = map_query_blocks(diff_block, dq[..., :DIFF_HD], dq[..., DIFF_HD:])
    out_b = rms_norm(out_b, g_sub) * (1.0 - lam_init)
    merged = jnp.concatenate([out_a.transpose(0, 2, 1, 3).reshape(B, T, H_A * V_HD_A),
                              out_b.transpose(0, 2, 1, 3).reshape(B, T, H_B * DIFF_VD)], axis=-1)
    return merged @ w_out, own


def mlstm_chunked(q, k, v, li, lf, C0, n0, m0):
    B, H, T, dk = q.shape
    dv = v.shape[-1]
    L = MLSTM_CHUNK
    nc = T // L
    f32 = jnp.float32
    qc = q.astype(f32).reshape(B, H, nc, L, dk)
    kc = k.astype(f32).reshape(B, H, nc, L, dk)
    vc = v.astype(f32).reshape(B, H, nc, L, dv)
    lic = li.reshape(B, H, nc, L)
    b = jnp.cumsum(lf.reshape(B, H, nc, L), axis=-1)
    g = b[..., -1]
    a = g[..., None] - b + lic
    a_max = jnp.max(a, axis=-1)
    w = jnp.exp(a - a_max[..., None])
    kv_chunk = jnp.einsum('bhcl,bhcld,bhcle->bhcde', w, kc, vc)
    kn_chunk = jnp.einsum('bhcl,bhcld->bhcd', w, kc)

    def step(carry, inp):
        C, n, m = carry
        g_j, am_j, kv_j, kn_j = inp
        m_new = jnp.maximum(g_j + m, am_j)
        s_old = jnp.exp(g_j + m - m_new)
        s_new = jnp.exp(am_j - m_new)
        C_new = s_old[..., None, None] * C + s_new[..., None, None] * kv_j
        n_new = s_old[..., None] * n + s_new[..., None] * kn_j
        return (C_new, n_new, m_new), (C, n, m)

    xs = (jnp.moveaxis(g, 2, 0), jnp.moveaxis(a_max, 2, 0), jnp.moveaxis(kv_chunk, 2, 0), jnp.moveaxis(kn_chunk, 2, 0))
    init = (C0.astype(f32), n0.astype(f32), m0.astype(f32))
    (Cf, nf, mf), (Cp, np_, mp) = lax.scan(step, init, xs)
    Cp = jnp.moveaxis(Cp, 0, 2)
    np_ = jnp.moveaxis(np_, 0, 2)
    mp = jnp.moveaxis(mp, 0, 2)
    mask = jnp.tril(jnp.ones((L, L), dtype=bool))
    dlog = jnp.where(mask, b[..., :, None] - b[..., None, :] + lic[..., None, :], -jnp.inf)
    m_inter = b + mp[..., None]
    m_t = jnp.maximum(m_inter, jnp.max(dlog, axis=-1))
    s = jnp.einsum('bhcld,bhcsd->bhcls', qc, kc) * jnp.exp(dlog - m_t[..., None])
    inter = jnp.exp(m_inter - m_t)
    num = jnp.einsum('bhcls,bhcse->bhcle', s, vc) + inter[..., None] * jnp.einsum('bhcld,bhcde->bhcle', qc, Cp)
    den = jnp.sum(s, axis=-1) + inter * jnp.einsum('bhcld,bhcd->bhcl', qc, np_)
    h = num / jnp.maximum(jnp.abs(den), jnp.exp(-m_t))[..., None]
    return h.reshape(B, H, T, dv), Cf, nf, mf


def odd_mixer(h, w_in, b_gate, g_norm, w_out, C0, n0, m0):
    B, T, _ = h.shape
    s0 = H_C * DK_C
    q, k, v, o, gates = jnp.split(h @ w_in, [s0, 2 * s0, 2 * s0 + H_C * DV_C, 2 * s0 + 2 * H_C * DV_C], axis=-1)

    def heads(x, d):
        return x.reshape(B, T, H_C, d).transpose(0, 2, 1, 3)

    q = heads(q, DK_C)
    k = heads(k, DK_C) * (DK_C ** -0.5)
    v = heads(v, DV_C)
    gts = (gates.astype(jnp.float32) + b_gate.astype(jnp.float32)).reshape(B, T, 4, H_C).transpose(2, 0, 3, 1)
    li_f, lf_f = gts[0], jax.nn.log_sigmoid(gts[1])
    li_b, lf_b = gts[2], jax.nn.log_sigmoid(gts[3])
    h_f, Cf, nf, mf = mlstm_chunked(q, k, v, li_f, lf_f, C0[:, 0], n0[:, 0], m0[:, 0])

    def flip(x):
        return jnp.flip(x, axis=2)

    h_b, Cb, nb, mb = mlstm_chunked(flip(q), flip(k), flip(v), flip(li_b), flip(lf_b), C0[:, 1], n0[:, 1], m0[:, 1])
    hs = rms_norm(h_f + flip(h_b), g_norm).transpose(0, 2, 1, 3).reshape(B, T, H_C * DV_C)
    y = (hs.astype(h.dtype) * jax.nn.sigmoid(o)) @ w_out
    return y, (jnp.stack([Cf, Cb], axis=1), jnp.stack([nf, nb], axis=1), jnp.stack([mf, mb], axis=1))


def setup_inputs(seed: int = 0) -> dict:
    key = jax.random.key(seed)
    ks = iter(jax.random.split(key, 40))

    def nrm(shape, scale=1.0):
        return scale * jax.random.normal(next(ks), shape, jnp.float32)

    def gain(shape):
        return 1.0 + nrm(shape, 0.05)

    gate_offsets = jnp.repeat(jnp.array([I_BIAS_INIT, F_BIAS_INIT, I_BIAS_INIT, F_BIAS_INIT], jnp.float32), H_C)
    return {
        'x_prompt': nrm((BATCH, SEQ, D_MODEL)),
        'x_sample': nrm((DEC_BATCH, DEC_SEQ, D_MODEL)),
        'cache_mla_ckv': nrm((DEC_BATCH, N_EVEN, PAST_LEN, KV_LORA)),
        'cache_mla_krope': nrm((DEC_BATCH, N_EVEN, PAST_LEN, QK_ROPE)),
        'cache_diff_k': nrm((DEC_BATCH, N_EVEN, H_B, PAST_LEN, 2 * DIFF_HD)),
        'cache_diff_v': nrm((DEC_BATCH, N_EVEN, H_B, PAST_LEN, DIFF_VD)),
        'state_mlstm_C': nrm((DEC_BATCH, N_ODD, 2, H_C, DK_C, DV_C), 0.3),
        'state_mlstm_n': nrm((DEC_BATCH, N_ODD, 2, H_C, DK_C), 0.3),
        'state_mlstm_m': nrm((DEC_BATCH, N_ODD, 2, H_C)),
        'c': nrm((DEC_BATCH, D_MODEL)),
        'c_ctx': nrm((D_MODEL,)),
        'w_ada': nrm((DEPTH, D_MODEL, 6 * D_MODEL), 0.5 * D_MODEL ** -0.5),
        'b_ada': nrm((DEPTH, 6 * D_MODEL), 0.1),
        'g_mix': gain((DEPTH, D_MODEL)),
        'g_ffn': gain((DEPTH, D_MODEL)),
        'w_ffn_in': nrm((DEPTH, D_MODEL, 2 * D_FF), D_MODEL ** -0.5),
        'w_ffn_out': nrm((DEPTH, D_FF, D_MODEL), D_FF ** -0.5),
        'w_in_ab': nrm((N_EVEN, D_MODEL, IN_AB), D_MODEL ** -0.5),
        'g_q_lora': gain((N_EVEN, Q_LORA)),
        'g_kv_lora': gain((N_EVEN, KV_LORA)),
        'w_uq': nrm((N_EVEN, Q_LORA, H_A * (QK_NOPE + QK_ROPE)), Q_LORA ** -0.5),
        'w_ukv': nrm((N_EVEN, KV_LORA, H_A * (QK_NOPE + V_HD_A)), KV_LORA ** -0.5),
        'diff_lambda': nrm((N_EVEN, 4, DIFF_HD), 0.1),
        'g_diff_subln': gain((N_EVEN, DIFF_VD)),
        'w_out_ab': nrm((N_EVEN, OUT_AB, D_MODEL), OUT_AB ** -0.5),
        'w_in_c': nrm((N_ODD, D_MODEL, IN_C), D_MODEL ** -0.5),
        'b_gate_c': gate_offsets[None, :] + nrm((N_ODD, 4 * H_C), 0.1),
        'g_mlstm': gain((N_ODD, DV_C)),
        'w_out_c': nrm((N_ODD, H_C * DV_C, D_MODEL), (H_C * DV_C) ** -0.5),
        'g_final': gain((D_MODEL,)),
    }


def reference(x_prompt, x_sample, cache_mla_ckv, cache_mla_krope, cache_diff_k, cache_diff_v,
              state_mlstm_C, state_mlstm_n, state_mlstm_m, c, c_ctx,
              w_ada, b_ada, g_mix, g_ffn, w_ffn_in, w_ffn_out,
              w_in_ab, g_q_lora, g_kv_lora, w_uq, w_ukv, diff_lambda, g_diff_subln, w_out_ab,
              w_in_c, b_gate_c, g_mlstm, w_out_c, g_final):
    pos = grid_positions(x_sample.shape[1])
    xp, xs = x_prompt, x_sample
    ckv_l, kr_l, dk_l, dv_l, C_l, n_l, m_l = [], [], [], [], [], [], []
    for l in range(DEPTH):
        j = l // 2
        p_sh1, p_sc1, p_g1, p_sh2, p_sc2, p_g2 = adaln(c_ctx[None], w_ada[l], b_ada[l])
        s_sh1, s_sc1, s_g1, s_sh2, s_sc2, s_g2 = adaln(c, w_ada[l], b_ada[l])
        hp = modulate(xp, g_mix[l], p_sh1, p_sc1)
        hs = modulate(xs, g_mix[l], s_sh1, s_sc1)
        if l % 2 == 0:
            ep = (w_in_ab[j], g_q_lora[j], g_kv_lora[j], w_uq[j], w_ukv[j], diff_lambda[j], g_diff_subln[j], w_out_ab[j])
            lam_init = 0.8 - 0.6 * math.exp(-0.3 * l)
            yp, (ckv_p, kr_p, dk_p, dv_p) = even_mixer(hp, *ep, lam_init)
            ctx = (cache_mla_ckv[:, j], cache_mla_krope[:, j], cache_diff_k[:, j], cache_diff_v[:, j])
            ys, _ = even_mixer(hs, *ep, lam_init, pos, ctx)
            ckv_l.append(ckv_p)
            kr_l.append(kr_p)
            dk_l.append(dk_p)
            dv_l.append(dv_p)
        else:
            op = (w_in_c[j], b_gate_c[j], g_mlstm[j], w_out_c[j])
            Bp = xp.shape[0]
            z_C = jnp.zeros((Bp, 2, H_C, DK_C, DV_C), jnp.float32)
            z_n = jnp.zeros((Bp, 2, H_C, DK_C), jnp.float32)
            z_m = jnp.zeros((Bp, 2, H_C), jnp.float32)
            yp, (C_p, n_p, m_p) = odd_mixer(hp, *op, z_C, z_n, z_m)
            ys, _ = odd_mixer(hs, *op, state_mlstm_C[:, j], state_mlstm_n[:, j], state_mlstm_m[:, j])
            C_l.append(C_p)
            n_l.append(n_p)
            m_l.append(m_p)
        xp = xp + p_g1 * yp
        xs = xs + s_g1 * ys
        xp = xp + p_g2 * swiglu(modulate(xp, g_ffn[l], p_sh2, p_sc2), w_ffn_in[l], w_ffn_out[l])
        xs = xs + s_g2 * swiglu(modulate(xs, g_ffn[l], s_sh2, s_sc2), w_ffn_in[l], w_ffn_out[l])
    y_prompt = rms_norm(xp, g_final)
    y_sample = rms_norm(xs, g_final)
    new_mla_ckv = jnp.stack(ckv_l, axis=1)
    new_mla_krope = jnp.stack(kr_l, axis=1)
    new_diff_k = jnp.stack(dk_l, axis=1)
    new_diff_v = jnp.stack(dv_l, axis=1)
    new_mlstm_C = jnp.stack(C_l, axis=1)
    new_mlstm_n = jnp.stack(n_l, axis=1)
    new_mlstm_m = jnp.stack(m_l, axis=1)
    return (y_prompt, y_sample, new_mla_ckv, new_mla_krope, new_diff_k, new_diff_v, new_mlstm_C, new_mlstm_n, new_mlstm_m)
```

```cpp
#include <hip/hip_runtime.h>
#include <hip/hip_cooperative_groups.h>
#include <cstdio>
#include <cstdint>
namespace cg = cooperative_groups;
__device__ __forceinline__ int ltid() { int t = threadIdx.x; asm volatile("" : "+v"(t)); return t; }
__device__ __forceinline__ int lbid() { int b = blockIdx.x; asm volatile("" : "+s"(b)); return b; }
#define MK_COOP 1
namespace pg8 {
#define PG8_LAS __attribute__((address_space(3)))
typedef unsigned short bf16_t;
typedef short bf16x8 __attribute__((ext_vector_type(8)));
typedef float f32x4 __attribute__((ext_vector_type(4)));
typedef unsigned u32x4 __attribute__((ext_vector_type(4)));
constexpr int BM = 256, BK = 64, HALF = 128, HTB = HALF * BK * 2  , STAGE_BYTES = 8 * HTB, NXCD = 8, WGM = 8;

__host__ __device__ __forceinline__ int lds_byte(int r, int c) { const int st = (r >> 4) * 2 + (c >> 5), rr = r & 15, cc = c & 31, ob = rr * 64 + cc * 2; return st * 1024 + (ob ^ (((ob >> 9) & 1) << 5)); }
__host__ __device__ __forceinline__ void stage_rc(int b, int& R, int& C) { const int st = b / 1024, sb = b % 1024, swz = sb ^ (((sb >> 9) & 1) << 5); R = (st >> 1) * 16 + swz / 64; C = (st & 1) * 32 + (swz % 64) / 2; }
__host__ __device__ __forceinline__ int perm32(int rho) { const int n = rho >> 4, i = rho & 15; return 8 * (i >> 2) + 4 * n + (i & 3); }

struct Unit { int pm, pn; };
struct Gemm { const bf16_t* A; const bf16_t* Bt; int M, N, K; };

struct StaticOrder {
    int nM, nN, nwg, G, c;
    __host__ __device__ void init(int M, int N, int G_, int c_) { nM = M / BM; nN = N / BM; nwg = nM * nN; G = G_; c = c_; }
    __host__ __device__ bool next(int i, Unit& u) const {
        const long L = (long)i * G + c; if (L >= nwg) return false;
        int wgid = (int)L; { const int q = nwg / NXCD, r = nwg % NXCD, xcd = wgid % NXCD, off = wgid / NXCD; wgid = (xcd < r ? xcd * (q + 1) : r * (q + 1) + (xcd - r) * q) + off; }
        const int nig = WGM * nN, gid = wgid / nig, fm = gid * WGM, gsz = (nM - fm) < WGM ? (nM - fm) : WGM;
        u.pm = fm + ((wgid % nig) % gsz); u.pn = (wgid % nig) / gsz; return true;
    }
    __device__ __forceinline__ void a_ready(const Unit&) const {}
    __device__ __forceinline__ void done(const Unit&) const {}
};

__device__ __forceinline__ unsigned cvt_pk_bf16(float lo, float hi) { unsigned r; asm volatile("v_cvt_pk_bf16_f32 %0, %1, %2" : "=v"(r) : "v"(lo), "v"(hi)); return r; }
typedef float f32x2 __attribute__((ext_vector_type(2)));
__device__ __forceinline__ f32x2 gelu_pk(f32x2 v) {
    const f32x2 av = __builtin_elementwise_abs(v), d = av * 0.2316418882f + 1.0f;
    f32x2 t; t.x = __builtin_amdgcn_rcpf(d.x); t.y = __builtin_amdgcn_rcpf(d.y);
    f32x2 q = t * 0.5307027145f + (-0.7265760135f); q = q * t + 0.7107068705f; q = q * t + (-0.142248368f); q = q * t + 0.127414796f; q = q * t;
    const f32x2 s = (v * v) * (-0.72134752044f);
    f32x2 e; e.x = __builtin_amdgcn_exp2f(s.x); e.y = __builtin_amdgcn_exp2f(s.y);
    const f32x2 m = v * (q * e), r = v - m;
    f32x2 o; o.x = v.x < 0.f ? m.x : r.x; o.y = v.y < 0.f ? m.y : r.y; return o;
}

template <int ACT  > struct EpiBf16 {
    static constexpr bool PERM = true, AFTER_DRAIN = false; static_assert(ACT == 0 || ACT == 1, "EpiBf16: ACT is 0 (none) or 1 (gelu_pk)");
    bf16_t* O; int ldc; const float* bias; int split_cols; size_t split_stride; float scale0;
    __device__ __forceinline__ void operator()(const f32x4 (&acc)[2][2][4][2], const Unit& u, int wr, int wc, int fr, int fq) const {
        const int row0 = u.pm * BM + wr * 64 + fr; int colt = u.pn * BM; bf16_t* base = O;
        float sc = 1.f; if (split_cols) { const int t = colt / split_cols; base += (size_t)t * split_stride; colt -= t * split_cols; if (t == 0) sc = scale0; }
        const int col0 = colt + wc * 32 + 8 * fq, bcol0 = u.pn * BM + wc * 32 + 8 * fq;
        f32x4 bv[2][2];
#pragma unroll
        for (int bj = 0; bj < 2; ++bj)
#pragma unroll
            for (int n = 0; n < 2; ++n) bv[bj][n] = bias ? *(const f32x4*)(bias + bcol0 + bj * HALF + 4 * n) : (f32x4){0.f, 0.f, 0.f, 0.f};
#pragma unroll
        for (int ai = 0; ai < 2; ++ai)
#pragma unroll
            for (int m = 0; m < 4; ++m) { bf16_t* rowp = base + (size_t)(row0 + ai * HALF + m * 16) * ldc + col0;
#pragma unroll
                for (int bj = 0; bj < 2; ++bj) { f32x4 v0 = acc[ai][bj][m][0] + bv[bj][0], v1 = acc[ai][bj][m][1] + bv[bj][1];
                    if (ACT == 1) { f32x2 a = gelu_pk((f32x2){v0[0], v0[1]}), b = gelu_pk((f32x2){v0[2], v0[3]}), c = gelu_pk((f32x2){v1[0], v1[1]}), d = gelu_pk((f32x2){v1[2], v1[3]});
                        v0 = (f32x4){a.x, a.y, b.x, b.y}; v1 = (f32x4){c.x, c.y, d.x, d.y}; }
                    v0 = v0 * sc; v1 = v1 * sc; u32x4 w; w.x = cvt_pk_bf16(v0[0], v0[1]); w.y = cvt_pk_bf16(v0[2], v0[3]); w.z = cvt_pk_bf16(v1[0], v1[1]); w.w = cvt_pk_bf16(v1[2], v1[3]);
                    *(u32x4*)(rowp + bj * HALF) = w; } }
    }
};
template <class Epi, class Sched, bool ALIGN_EPI = false, bool SP2 = false>
__device__ __forceinline__ void gemm_phase(PG8_LAS unsigned char* lds, const Gemm g, const Sched& S, const Epi& E) {
    const int tid = ltid(), wid = __builtin_amdgcn_readfirstlane(tid >> 6), lane = tid & 63, wr = wid >> 2, wc = wid & 3, fr = lane & 15, fq = lane >> 4;
    const int K = g.K, nt = K / BK;
    unsigned voffA[2], voffB[2];
#pragma unroll
    for (int i = 0; i < 2; ++i) { int R, C; stage_rc(tid * 16 + i * 8192, R, C); const int Rb = Epi::PERM ? ((R & ~31) + perm32(R & 31)) : R;
        voffA[i] = (unsigned)(R * K + C) * 2u; voffB[i] = (unsigned)(Rb * K + C) * 2u; }
    const size_t kstep = (size_t)(BK * 2);
    const size_t hstep = (size_t)HALF * K * 2;
    const size_t tstep = 2 * hstep;
    const unsigned ldsw = (unsigned)wid * 1024u;
    const int aoff = lds_byte(wr * 64 + fr, fq * 8), boff = lds_byte(wc * 32 + fr, fq * 8);
#define PG8_SA(b, h) (((b) * 2 + (h)) * HTB)
#define PG8_SB(b, h) ((4 + (b) * 2 + (h)) * HTB)
#define PG8_STAGE(bufoff, gbase, voff) do { _Pragma("unroll") for (int _i = 0; _i < 2; ++_i) \
        __builtin_amdgcn_global_load_lds((const unsigned*)((const char*)(gbase) + (voff)[_i]), (PG8_LAS unsigned*)(lds + (bufoff) + ldsw + _i * 8192), 16, 0, 0); } while (0)
#define PG8_LDA(dst, b, h) do { _Pragma("unroll") for (int m = 0; m < 4; ++m) _Pragma("unroll") for (int k = 0; k < 2; ++k) dst[m][k] = *(const PG8_LAS bf16x8*)(lds + PG8_SA(b, h) + aoff + m * 2048 + k * 1024); } while (0)
#define PG8_LDB(dst, b, h) do { _Pragma("unroll") for (int n = 0; n < 2; ++n) _Pragma("unroll") for (int k = 0; k < 2; ++k) dst[n][k] = *(const PG8_LAS bf16x8*)(lds + PG8_SB(b, h) + boff + n * 2048 + k * 1024); } while (0)
#define PG8_MMA(ai, bj, At, Bt) do { __builtin_amdgcn_s_setprio(1); _Pragma("unroll") for (int m = 0; m < 4; ++m) _Pragma("unroll") for (int n = 0; n < 2; ++n) _Pragma("unroll") for (int k = 0; k < 2; ++k) \
        acc[ai][bj][m][n] = __builtin_amdgcn_mfma_f32_16x16x32_bf16(Bt[n][k], At[m][k], acc[ai][bj][m][n], 0, 0, 0); __builtin_amdgcn_s_setprio(0); } while (0)
#define PG8_WAIT_V(n) asm volatile("s_waitcnt vmcnt(" #n ")" ::: "memory")
#define PG8_WAIT_L(n) asm volatile("s_waitcnt lgkmcnt(" #n ")" ::: "memory")
#define PG8_BAR __builtin_amdgcn_s_barrier()
#define PG8_SCHED __builtin_amdgcn_sched_barrier(0)
    Unit cur, nxt; int ui = 0;
    if (!S.next(0, cur)) return;
    f32x4 acc[2][2][4][2];
#pragma unroll
    for (int a = 0; a < 2; ++a)
#pragma unroll
        for (int b = 0; b < 2; ++b)
#pragma unroll
            for (int m = 0; m < 4; ++m)
#pragma unroll
                for (int n = 0; n < 2; ++n) acc[a][b][m][n] = (f32x4){0.f, 0.f, 0.f, 0.f};
    bf16x8 At[4][2], B0[2][2], B1[2][2];
    const char* cA = (const char*)g.A + (size_t)cur.pm * tstep; const char* cB = (const char*)g.Bt + (size_t)cur.pn * tstep;
    S.a_ready(cur);
    if constexpr (SP2) {
        PG8_STAGE(PG8_SB(0, 0), cB, voffB); PG8_STAGE(PG8_SB(0, 1), cB + hstep, voffB); PG8_STAGE(PG8_SA(0, 0), cA, voffA); PG8_STAGE(PG8_SA(0, 1), cA + hstep, voffA);
        if (wr == 1) PG8_BAR;
        PG8_WAIT_V(2); PG8_BAR;
        PG8_STAGE(PG8_SB(1, 0), cB + kstep, voffB); PG8_STAGE(PG8_SA(1, 0), cA + kstep, voffA); PG8_STAGE(PG8_SB(1, 1), cB + hstep + kstep, voffB);
        PG8_WAIT_V(6); PG8_BAR;
    } else {
        PG8_STAGE(PG8_SB(0, 0), cB, voffB); PG8_STAGE(PG8_SA(0, 0), cA, voffA); PG8_STAGE(PG8_SB(0, 1), cB + hstep, voffB); PG8_STAGE(PG8_SA(0, 1), cA + hstep, voffA);
        if (wr == 1) PG8_BAR;
        PG8_WAIT_V(4); PG8_BAR;
        PG8_STAGE(PG8_SB(1, 0), cB + kstep, voffB); PG8_STAGE(PG8_SA(1, 0), cA + kstep, voffA); PG8_STAGE(PG8_SB(1, 1), cB + hstep + kstep, voffB);
        PG8_WAIT_V(6); PG8_BAR;
    }
    for (;;) {
        const bool has_next = S.next(ui + 1, nxt);
        const char* nA = has_next ? (const char*)g.A + (size_t)nxt.pm * tstep : cA; const char* nB = has_next ? (const char*)g.Bt + (size_t)nxt.pn * tstep : cB;
        for (int t = 0; t < nt; t += 2) {
            const bool last = (t == nt - 2);
            const char* a1 = cA + (size_t)(t + 1) * kstep;
            const char* a2 = last ? nA : cA + (size_t)(t + 2) * kstep; const char* b2 = last ? nB : cB + (size_t)(t + 2) * kstep;
            const char* a3 = a2 + kstep; const char* b3 = b2 + kstep;
            if (last && has_next) S.a_ready(nxt);
            if constexpr (SP2) {
            PG8_LDB(B0, 0, 0); PG8_LDB(B1, 0, 1); PG8_SCHED; PG8_LDA(At, 0, 0); PG8_STAGE(PG8_SA(1, 1), a1 + hstep, voffA);
            PG8_WAIT_V(8); PG8_WAIT_L(0); PG8_BAR; PG8_MMA(0, 0, At, B0); PG8_MMA(0, 1, At, B1); PG8_BAR; PG8_SCHED;
            PG8_LDA(At, 0, 1); PG8_STAGE(PG8_SB(0, 0), b2, voffB); PG8_STAGE(PG8_SB(0, 1), b2 + hstep, voffB); PG8_STAGE(PG8_SA(0, 0), a2, voffA);
            PG8_WAIT_V(8); PG8_WAIT_L(0); PG8_BAR; PG8_MMA(1, 0, At, B0); PG8_MMA(1, 1, At, B1); PG8_BAR; PG8_SCHED;
            PG8_LDB(B0, 1, 0); PG8_LDB(B1, 1, 1); PG8_SCHED; PG8_LDA(At, 1, 0); PG8_STAGE(PG8_SA(0, 1), a2 + hstep, voffA);
            PG8_WAIT_V(8); PG8_WAIT_L(0); PG8_BAR; PG8_MMA(0, 0, At, B0); PG8_MMA(0, 1, At, B1); PG8_BAR; PG8_SCHED;
            PG8_LDA(At, 1, 1); PG8_STAGE(PG8_SB(1, 0), b3, voffB); PG8_STAGE(PG8_SB(1, 1), b3 + hstep, voffB); PG8_STAGE(PG8_SA(1, 0), a3, voffA);
            PG8_WAIT_V(8); PG8_WAIT_L(0); PG8_BAR; PG8_MMA(1, 0, At, B0); PG8_MMA(1, 1, At, B1); PG8_BAR; PG8_SCHED;
            } else {
            PG8_LDB(B0, 0, 0); PG8_SCHED; PG8_LDA(At, 0, 0); PG8_STAGE(PG8_SA(1, 1), a1 + hstep, voffA);
            PG8_WAIT_L(8); PG8_BAR; PG8_WAIT_L(0); PG8_MMA(0, 0, At, B0); PG8_BAR; PG8_SCHED;
            PG8_LDB(B1, 0, 1); PG8_STAGE(PG8_SB(0, 0), b2, voffB);
            PG8_BAR; PG8_WAIT_L(0); PG8_MMA(0, 1, At, B1); PG8_BAR;
            PG8_LDA(At, 0, 1); PG8_STAGE(PG8_SA(0, 0), a2, voffA);
            PG8_BAR; PG8_WAIT_L(0); PG8_MMA(1, 0, At, B0); PG8_BAR; PG8_SCHED;
            PG8_STAGE(PG8_SB(0, 1), b2 + hstep, voffB);
            PG8_WAIT_V(6); PG8_BAR; PG8_MMA(1, 1, At, B1); PG8_BAR;
            PG8_LDB(B0, 1, 0); PG8_SCHED; PG8_LDA(At, 1, 0); PG8_STAGE(PG8_SA(0, 1), a2 + hstep, voffA);
            PG8_WAIT_L(8); PG8_BAR; PG8_WAIT_L(0); PG8_MMA(0, 0, At, B0); PG8_BAR; PG8_SCHED;
            PG8_LDB(B1, 1, 1); PG8_STAGE(PG8_SB(1, 0), b3, voffB);
            PG8_BAR; PG8_WAIT_L(0); PG8_MMA(0, 1, At, B1); PG8_BAR;
            PG8_LDA(At, 1, 1); PG8_STAGE(PG8_SA(1, 0), a3, voffA);
            PG8_BAR; PG8_WAIT_L(0); PG8_MMA(1, 0, At, B0); PG8_BAR; PG8_SCHED;
            PG8_STAGE(PG8_SB(1, 1), b3 + hstep, voffB);
            PG8_WAIT_V(6); PG8_BAR; PG8_MMA(1, 1, At, B1); PG8_BAR;
            }
        }
        if constexpr (ALIGN_EPI) { if (wr == 0) PG8_BAR; }
        if constexpr (!Epi::AFTER_DRAIN) { E(acc, cur, wr, wc, fr, fq); S.done(cur); }
        if (!has_next) break;
#pragma unroll
        for (int a = 0; a < 2; ++a)
#pragma unroll
            for (int b = 0; b < 2; ++b)
#pragma unroll
                for (int m = 0; m < 4; ++m)
#pragma unroll
                    for (int n = 0; n < 2; ++n) acc[a][b][m][n] = (f32x4){0.f, 0.f, 0.f, 0.f};
        cur = nxt; cA = nA; cB = nB; ++ui;
        if constexpr (ALIGN_EPI) { if (wr == 1) PG8_BAR; }
    }
    PG8_WAIT_V(0);
    if constexpr (!ALIGN_EPI) { if (wr == 0) PG8_BAR; }
    PG8_BAR;
    if constexpr (Epi::AFTER_DRAIN) { E.fused(acc, cur, wr, wc, fr, fq, lds, wid, lane); S.done(cur); }
#undef PG8_SA
#undef PG8_SB
#undef PG8_STAGE
#undef PG8_LDA
#undef PG8_LDB
#undef PG8_MMA
#undef PG8_WAIT_V
#undef PG8_WAIT_L
#undef PG8_BAR
#undef PG8_SCHED
}
}

#define LAS __attribute__((address_space(3)))
typedef unsigned short bf16;
typedef short bf16x8 __attribute__((ext_vector_type(8)));
typedef float f32x4 __attribute__((ext_vector_type(4)));
typedef float f32x16 __attribute__((ext_vector_type(16)));
typedef unsigned u32x4 __attribute__((ext_vector_type(4)));
typedef unsigned u32x2 __attribute__((ext_vector_type(2)));

constexpr int NTHREADS = 512, NWAVES = 8;
constexpr int LDS_BYTES = 147456;
constexpr int MTOK = 16384, NPROMPT = 8192, KVROWS = 18432;
constexpr float RMS_EPS = 1e-6f;
constexpr size_t MiB = 1u << 20;
constexpr size_t WS_MOD = 0, WS_ROPE8 = 512 * 1024, WS_ROPE16 = WS_ROPE8 + 4096;
constexpr size_t WS_W_INAB = 1 * MiB, WS_W_UQ = 5 * MiB, WS_W_UKV = 5 * MiB + 512 * 1024, WS_W_OUTAB = 6 * MiB, WS_W_FFI = 8 * MiB, WS_W_FFO = 30 * MiB,
                 WS_W_INC = 41 * MiB, WS_W_OUTC = 48 * MiB;
constexpr size_t WS_X = 50 * MiB;
constexpr size_t WS_CQN = 50 * MiB, WS_CKVA = 58 * MiB, WS_KR = 67 * MiB, WS_DQ = 69 * MiB, WS_DK = 85 * MiB, WS_DV = 103 * MiB;
constexpr size_t WS_H = 114 * MiB, WS_Y = 146 * MiB, WS_QA = 121 * MiB, WS_KVA = 146 * MiB, WS_MERGED = 182 * MiB, WS_HID = 146 * MiB;
constexpr size_t WS_NP = 250 * MiB, WS_MP = 251 * MiB, WS_HS = 114 * MiB, WS_END = 256 * MiB;
constexpr size_t OUT_Y = 0, OUT_CKV = 16777216, OUT_KR = 17825792, OUT_DK = 18087936, OUT_DV = 22282240, OUT_C = 26476544, OUT_N = 30670848, OUT_M = 30703616;

struct Args { const float* in[30]; float* out; unsigned char* ws; int ph_lo, ph_hi; };

__device__ __forceinline__ unsigned f2bf(float f) { unsigned u = __float_as_uint(f); return (u + 0x7fffu + ((u >> 16) & 1u)) >> 16; }
__device__ __forceinline__ unsigned pk2(float lo, float hi) { return pg8::cvt_pk_bf16(lo, hi); }
__device__ __forceinline__ float bflo(unsigned w) { return __uint_as_float(w << 16); }
__device__ __forceinline__ float bfhi(unsigned w) { return __uint_as_float(w & 0xffff0000u); }
__device__ __forceinline__ float bf2f(bf16 b) { return __uint_as_float(((unsigned)b) << 16); }
__device__ __forceinline__ float wave_sum(float v) {
#pragma unroll
    for (int o = 1; o < 64; o <<= 1) v += __shfl_xor(v, o);
    return v;
}
__device__ __forceinline__ float wave_max(float v) {
#pragma unroll
    for (int o = 1; o < 64; o <<= 1) v = fmaxf(v, __shfl_xor(v, o));
    return v;
}
__device__ __forceinline__ float scan_sum(float v, int lane) {
#pragma unroll
    for (int o = 1; o < 64; o <<= 1) { float t = __shfl_up(v, o); if (lane >= o) v += t; }
    return v;
}
__device__ __forceinline__ float scan_max(float v, int lane) {
#pragma unroll
    for (int o = 1; o < 64; o <<= 1) { float t = __shfl_up(v, o); if (lane >= o) v = fmaxf(v, t); }
    return v;
}
__device__ __forceinline__ float log_sigmoid(float x) { return fminf(x, 0.f) - log1pf(expf(-fabsf(x))); }
__device__ __forceinline__ f32x16 mfma32(bf16x8 a, bf16x8 b, f32x16 c) { return __builtin_amdgcn_mfma_f32_32x32x16_bf16(a, b, c, 0, 0, 0); }
__device__ __forceinline__ bf16x8 pack8(float a0, float a1, float a2, float a3, float a4, float a5, float a6, float a7) {
    u32x4 w; w.x = pk2(a0, a1); w.y = pk2(a2, a3); w.z = pk2(a4, a5); w.w = pk2(a6, a7); return __builtin_bit_cast(bf16x8, w);
}

struct EpiGate {
    static constexpr bool PERM = true, AFTER_DRAIN = false;
    const float* baseP; const float* baseS; float* out; const float* mod;
    __device__ __forceinline__ void operator()(const pg8::f32x4 (&acc)[2][2][4][2], const pg8::Unit& u, int wr, int wc, int fr, int fq) const {
        const int rowb = u.pm * 256; const int n = rowb < NPROMPT ? 0 : 1 + ((rowb - NPROMPT) >> 10);
        const int row0 = rowb + wr * 64 + fr, col0 = u.pn * 256 + wc * 32 + 8 * fq;
        const float* gp = mod + n * 6144 + col0;
        f32x4 gv[2][2];
#pragma unroll
        for (int bj = 0; bj < 2; ++bj) { gv[bj][0] = *(const f32x4*)(gp + bj * 128); gv[bj][1] = *(const f32x4*)(gp + bj * 128 + 4); }
        const float* bb = rowb < NPROMPT ? baseP + (size_t)row0 * 1024 : baseS + (size_t)(row0 - NPROMPT) * 1024;
#pragma unroll
        for (int ai = 0; ai < 2; ++ai)
#pragma unroll
            for (int m = 0; m < 4; ++m) {
                const size_t ro = (size_t)(ai * 128 + m * 16) * 1024 + col0;
                float* op = out + (size_t)row0 * 1024 + ro;
#pragma unroll
                for (int bj = 0; bj < 2; ++bj) {
                    const f32x4 x0 = *(const f32x4*)(bb + ro + bj * 128), x1 = *(const f32x4*)(bb + ro + bj * 128 + 4);
                    *(f32x4*)(op + bj * 128) = x0 + gv[bj][0] * acc[ai][bj][m][0];
                    *(f32x4*)(op + bj * 128 + 4) = x1 + gv[bj][1] * acc[ai][bj][m][1];
                }
            }
    }
};
struct EpiSwiGLU {
    static constexpr bool PERM = true, AFTER_DRAIN = false;
    bf16* O;
    __device__ __forceinline__ void operator()(const pg8::f32x4 (&acc)[2][2][4][2], const pg8::Unit& u, int wr, int wc, int fr, int fq) const {
        const int row0 = u.pm * 256 + wr * 64 + fr, col0 = u.pn * 128 + wc * 32 + 8 * fq;
#pragma unroll
        for (int ai = 0; ai < 2; ++ai)
#pragma unroll
            for (int m = 0; m < 4; ++m) {
                float hv[8];
#pragma unroll
                for (int n = 0; n < 2; ++n)
#pragma unroll
                    for (int i = 0; i < 4; ++i) { const float av = acc[ai][0][m][n][i], bv = acc[ai][1][m][n][i]; hv[n * 4 + i] = av * bv * __builtin_amdgcn_rcpf(1.f + __expf(-av)); }
                u32x4 w; w.x = pk2(hv[0], hv[1]); w.y = pk2(hv[2], hv[3]); w.z = pk2(hv[4], hv[5]); w.w = pk2(hv[6], hv[7]);
                *(u32x4*)(O + (size_t)(row0 + ai * 128 + m * 16) * 2816 + col0) = w;
            }
    }
};

__device__ __forceinline__ void tr_item(const float* W, int N, bf16* WT, int ldk, int k0, int n0, int drow0, float* scr, int lane) {
#pragma unroll 8
    for (int i = 0; i < 32; ++i) { const int kk = 2 * i + (lane >> 5); scr[kk * 33 + (lane & 31)] = W[(size_t)(k0 + kk) * N + n0 + (lane & 31)]; }
    __builtin_amdgcn_s_waitcnt(0); asm volatile("" ::: "memory");
    const int c = lane & 7;
#pragma unroll
    for (int j = 0; j < 4; ++j) { const int n = (lane >> 3) + 8 * j; const float* s = scr + (8 * c) * 33 + n;
        u32x4 o; o.x = pk2(s[0 * 33], s[1 * 33]); o.y = pk2(s[2 * 33], s[3 * 33]); o.z = pk2(s[4 * 33], s[5 * 33]); o.w = pk2(s[6 * 33], s[7 * 33]);
        *(u32x4*)(WT + (size_t)(drow0 + n) * ldk + k0 + 8 * c) = o; }
    __builtin_amdgcn_s_waitcnt(0); asm volatile("" ::: "memory");
}

__device__ __forceinline__ void phase_prep(const Args& a, unsigned char* lds) {
    const int tid = ltid(), lane = tid & 63, wave = tid >> 6, G = gridDim.x;
    unsigned char* ws = a.ws;
    float* MOD = (float*)(ws + WS_MOD);
    if (lbid() < 192) {
        float* sS = (float*)lds; float* sRed = sS + 1024 * 12;
        for (int idx = tid; idx < 9 * 1024; idx += NTHREADS) { const int n = idx >> 10, k = idx & 1023; const float c = n == 0 ? a.in[10][k] : a.in[9][(n - 1) * 1024 + k]; sS[k * 12 + n] = c / (1.f + expf(-c)); }
        __syncthreads();
        for (int it = lbid(); it < 192; it += G) {
            const int l = it / 96, j0 = (it % 96) * 64, kg = tid >> 6, jl = tid & 63;
            const float* W = a.in[11] + ((size_t)l * 1024 + kg * 128) * 6144 + j0 + jl;
            float acc[9];
#pragma unroll
            for (int n = 0; n < 9; ++n) acc[n] = 0.f;
#pragma unroll 8
            for (int k = 0; k < 128; ++k) {
                const float w = W[(size_t)k * 6144]; const float* s = sS + (kg * 128 + k) * 12;
                const f32x4 s0 = *(const f32x4*)s, s1 = *(const f32x4*)(s + 4); const float s8 = s[8];
                acc[0] += w * s0.x; acc[1] += w * s0.y; acc[2] += w * s0.z; acc[3] += w * s0.w; acc[4] += w * s1.x; acc[5] += w * s1.y; acc[6] += w * s1.z; acc[7] += w * s1.w; acc[8] += w * s8;
            }
#pragma unroll
            for (int n = 0; n < 9; ++n) sRed[(kg * 64 + jl) * 9 + n] = acc[n];
            __syncthreads();
            for (int idx = tid; idx < 576; idx += NTHREADS) { const int n = idx >> 6, j2 = idx & 63; float s = a.in[12][l * 6144 + j0 + j2];
#pragma unroll
                for (int g = 0; g < 8; ++g) s += sRed[(g * 64 + j2) * 9 + n];
                MOD[(l * 9 + n) * 6144 + j0 + j2] = s; }
            __syncthreads();
        }
    }
    __syncthreads();
    if (lbid() == 0) {
        float* R8 = (float*)(ws + WS_ROPE8); float* R16 = (float*)(ws + WS_ROPE16);
        { const int pos = tid >> 3, i = tid & 7; const float fr = (float)pow(10000.0, -(double)i / 8.0); const float ang = (float)pos * fr; R8[tid * 2] = (float)cos((double)ang); R8[tid * 2 + 1] = (float)sin((double)ang); }
        for (int e = tid; e < 1024; e += NTHREADS) { const int pos = e >> 4, i = e & 15; const float fr = (float)pow(10000.0, -(double)i / 16.0); const float ang = (float)pos * fr; R16[e * 2] = (float)cos((double)ang); R16[e * 2 + 1] = (float)sin((double)ang); }
    }
    {
        const int gt = lbid() * NTHREADS + tid, NGT = G * NTHREADS; const u32x4 z = {0u, 0u, 0u, 0u};
        bf16* wukv = (bf16*)(ws + WS_W_UKV);
        for (int i = gt; i < 1024 * 16; i += NGT) *(u32x4*)(wukv + (size_t)(i >> 4) * 256 + 128 + (i & 15) * 8) = z;
        u32x4* p1 = (u32x4*)((bf16*)(ws + WS_W_INAB) + (size_t)1952 * 1024);
        for (int i = gt; i < 12288; i += NGT) p1[i] = z;
        u32x4* p2 = (u32x4*)((bf16*)(ws + WS_W_INC) + (size_t)3104 * 1024);
        for (int i = gt; i < 28672; i += NGT) p2[i] = z;
    }
    {
        float* scr = (float*)lds + wave * (64 * 33);
        const int gw = lbid() * NWAVES + wave, NGW = G * NWAVES;
        constexpr int NITEMS = 976 + 96 + 64 + 512 + 5632 + 2816 + 1552 + 512;
        for (int it = gw; it < NITEMS; it += NGW) {
            int r = it; const float* W; int N, ldk, mode = 0; bf16* WT;
            if (r < 976) { W = a.in[17]; N = 1952; WT = (bf16*)(ws + WS_W_INAB); ldk = 1024; }
            else if ((r -= 976) < 96) { W = a.in[20]; N = 768; WT = (bf16*)(ws + WS_W_UQ); ldk = 256; }
            else if ((r -= 96) < 64) { W = a.in[21]; N = 1024; WT = (bf16*)(ws + WS_W_UKV); ldk = 256; }
            else if ((r -= 64) < 512) { W = a.in[24]; N = 1024; WT = (bf16*)(ws + WS_W_OUTAB); ldk = 1024; }
            else if ((r -= 512) < 5632) { const int l = r / 2816; r -= l * 2816; W = a.in[15] + (size_t)l * 1024 * 5632; N = 5632; WT = (bf16*)(ws + WS_W_FFI) + (size_t)l * 5632 * 1024; ldk = 1024; mode = 1; }
            else if ((r -= 5632) < 2816) { const int l = r / 1408; r -= l * 1408; W = a.in[16] + (size_t)l * 2816 * 1024; N = 1024; WT = (bf16*)(ws + WS_W_FFO) + (size_t)l * 1024 * 2816; ldk = 2816; }
            else if ((r -= 2816) < 1552) { W = a.in[25]; N = 3104; WT = (bf16*)(ws + WS_W_INC); ldk = 1024; }
            else { r -= 1552; W = a.in[28]; N = 1024; WT = (bf16*)(ws + WS_W_OUTC); ldk = 1024; }
            const int nblk = N / 32, kb = r / nblk, nb = r % nblk, k0 = 64 * kb, n0 = 32 * nb;
            const int drow0 = mode ? ((n0 % 2816) / 128) * 256 + (n0 / 2816) * 128 + (n0 % 128) : n0;
            tr_item(W, N, WT, ldk, k0, n0, drow0, scr, lane);
        }
    }
}

__device__ __forceinline__ void phase_rowwise(const Args& a, int ph) {
    const int tid = ltid(), lane = tid & 63, wave = tid >> 6, G = gridDim.x;
    unsigned char* ws = a.ws;
    const int L = ph >= 10 ? 1 : 0;
    const bool fin = ph == 18, ffn = (ph == 7 || ph == 15);
    const float* g = fin ? a.in[29] : (ffn ? a.in[14] : a.in[13]) + L * 1024;
    const float* MOD = (const float*)(ws + WS_MOD) + (size_t)L * 9 * 6144 + (ffn ? 3072 : 0);
    const float* X = (const float*)(ws + WS_X); bf16* H = (bf16*)(ws + WS_H);
    f32x4 gv[4];
#pragma unroll
    for (int j = 0; j < 4; ++j) gv[j] = *(const f32x4*)(g + 4 * lane + 256 * j);
    for (int m = lbid() * NWAVES + wave; m < MTOK; m += G * NWAVES) {
        const float* xr = ph == 1 ? (m < NPROMPT ? a.in[0] + (size_t)m * 1024 : a.in[1] + (size_t)(m - NPROMPT) * 1024) : X + (size_t)m * 1024;
        f32x4 v[4]; float ss = 0.f;
#pragma unroll
        for (int j = 0; j < 4; ++j) { v[j] = *(const f32x4*)(xr + 4 * lane + 256 * j); ss += (v[j].x * v[j].x + v[j].y * v[j].y) + (v[j].z * v[j].z + v[j].w * v[j].w); }
        const float rstd = rsqrtf(wave_sum(ss) * (1.f / 1024.f) + RMS_EPS);
        if (fin) {
            float* o = a.out + OUT_Y + (size_t)m * 1024;
#pragma unroll
            for (int j = 0; j < 4; ++j) *(f32x4*)(o + 4 * lane + 256 * j) = v[j] * rstd * gv[j];
        } else {
            const int n = m < NPROMPT ? 0 : 1 + ((m - NPROMPT) >> 10);
            const float* sh = MOD + n * 6144; const float* sc = sh + 1024;
#pragma unroll
            for (int j = 0; j < 4; ++j) {
                const f32x4 s4 = *(const f32x4*)(sc + 4 * lane + 256 * j), h4 = *(const f32x4*)(sh + 4 * lane + 256 * j);
                const f32x4 y = v[j] * rstd * gv[j] * (1.f + s4) + h4;
                u32x2 w; w.x = pk2(y.x, y.y); w.y = pk2(y.z, y.w);
                *(u32x2*)(H + (size_t)m * 1024 + 4 * lane + 256 * j) = w;
            }
        }
    }
}

__device__ __forceinline__ void rope8(u32x4& w, const u32x4 p, const float* cs, bool second) {
    float x[8], y[8];
    x[0] = bflo(w.x); x[1] = bfhi(w.x); x[2] = bflo(w.y); x[3] = bfhi(w.y); x[4] = bflo(w.z); x[5] = bfhi(w.z); x[6] = bflo(w.w); x[7] = bfhi(w.w);
    y[0] = bflo(p.x); y[1] = bfhi(p.x); y[2] = bflo(p.y); y[3] = bfhi(p.y); y[4] = bflo(p.z); y[5] = bfhi(p.z); y[6] = bflo(p.w); y[7] = bfhi(p.w);
    float o[8];
#pragma unroll
    for (int j = 0; j < 8; ++j) { const float c = cs[2 * j], s = cs[2 * j + 1]; o[j] = second ? y[j] * s + x[j] * c : x[j] * c - y[j] * s; }
    w.x = pk2(o[0], o[1]); w.y = pk2(o[2], o[3]); w.z = pk2(o[4], o[5]); w.w = pk2(o[6], o[7]);
}
__device__ __forceinline__ u32x4 shfl_xor4(u32x4 v, int m) { u32x4 r; r.x = __shfl_xor(v.x, m); r.y = __shfl_xor(v.y, m); r.z = __shfl_xor(v.z, m); r.w = __shfl_xor(v.w, m); return r; }
__device__ __forceinline__ void st_f32x8(float* p, u32x4 w) {
    *(f32x4*)p = (f32x4){bflo(w.x), bfhi(w.x), bflo(w.y), bfhi(w.y)}; *(f32x4*)(p + 4) = (f32x4){bflo(w.z), bfhi(w.z), bflo(w.w), bfhi(w.w)};
}

__device__ __forceinline__ void phase_split(const Args& a) {
    const int tid = ltid(), lane = tid & 63, wave = tid >> 6, G = gridDim.x;
    unsigned char* ws = a.ws;
    const bf16* Y = (const bf16*)(ws + WS_Y);
    bf16* CQN = (bf16*)(ws + WS_CQN); bf16* CKVA = (bf16*)(ws + WS_CKVA); bf16* KR = (bf16*)(ws + WS_KR);
    bf16* DQ = (bf16*)(ws + WS_DQ); bf16* DK = (bf16*)(ws + WS_DK); bf16* DV = (bf16*)(ws + WS_DV);
    const float* R8 = (const float*)(ws + WS_ROPE8); const float* R16 = (const float*)(ws + WS_ROPE16);
    const float* gql = a.in[18]; const float* gkv = a.in[19];
    for (int kvrow = lbid() * NWAVES + wave; kvrow < KVROWS; kvrow += G * NWAVES) {
        int m, b, t; bool sample = false, cache = false;
        if (kvrow < NPROMPT) { m = kvrow; b = m >> 8; t = m & 255; }
        else { const int r = kvrow - NPROMPT; b = r / 1280; const int k = r - b * 1280; if (k < 1024) { sample = true; t = k; m = NPROMPT + b * 1024 + k; } else { cache = true; t = k - 1024; m = 0; } }
        *(unsigned*)(CKVA + (size_t)kvrow * 256 + 128 + 2 * lane) = 0u;
        if (cache) {
            const float* s = a.in[2] + (size_t)(b * 256 + t) * 128 + 2 * lane;
            *(unsigned*)(CKVA + (size_t)kvrow * 256 + 2 * lane) = pk2(s[0], s[1]);
            if (lane < 32) KR[(size_t)kvrow * 32 + lane] = (bf16)f2bf(a.in[3][(size_t)(b * 256 + t) * 32 + lane]);
            const int hb = lane >> 4; const size_t so = ((size_t)(b * 4 + hb) * 256 + t) * 128 + (lane & 15) * 8;
            { const f32x4 x0 = *(const f32x4*)(a.in[4] + so), x1 = *(const f32x4*)(a.in[4] + so + 4);
              u32x4 w; w.x = pk2(x0.x, x0.y); w.y = pk2(x0.z, x0.w); w.z = pk2(x1.x, x1.y); w.w = pk2(x1.z, x1.w); *(u32x4*)(DK + (size_t)kvrow * 512 + 8 * lane) = w; }
            { const f32x4 x0 = *(const f32x4*)(a.in[5] + so), x1 = *(const f32x4*)(a.in[5] + so + 4);
              u32x4 w; w.x = pk2(x0.x, x0.y); w.y = pk2(x0.z, x0.w); w.z = pk2(x1.x, x1.y); w.w = pk2(x1.z, x1.w); *(u32x4*)(DV + (size_t)kvrow * 512 + 8 * lane) = w; }
            continue;
        }
        const bf16* yr = Y + (size_t)m * 2048;
        const int grow = t >> 6, gcol = t & 63;
        { const u32x2 w = *(const u32x2*)(yr + 4 * lane); const float x0 = bflo(w.x), x1 = bfhi(w.x), x2 = bflo(w.y), x3 = bfhi(w.y);
          const float rstd = rsqrtf(wave_sum(x0 * x0 + x1 * x1 + x2 * x2 + x3 * x3) * (1.f / 256.f) + RMS_EPS);
          const f32x4 gq = *(const f32x4*)(gql + 4 * lane);
          u32x2 o; o.x = pk2(x0 * rstd * gq.x, x1 * rstd * gq.y); o.y = pk2(x2 * rstd * gq.z, x3 * rstd * gq.w);
          *(u32x2*)(CQN + (size_t)m * 256 + 4 * lane) = o; }
        { const unsigned w = *(const unsigned*)(yr + 256 + 2 * lane); const float x0 = bflo(w), x1 = bfhi(w);
          const float rstd = rsqrtf(wave_sum(x0 * x0 + x1 * x1) * (1.f / 128.f) + RMS_EPS);
          const float y0 = x0 * rstd * gkv[2 * lane], y1 = x1 * rstd * gkv[2 * lane + 1];
          if (!sample) { float* o = a.out + OUT_CKV + (size_t)m * 128 + 2 * lane; o[0] = y0; o[1] = y1; }
          *(unsigned*)(CKVA + (size_t)kvrow * 256 + 2 * lane) = pk2(y0, y1); }
        { float x = lane < 32 ? bf2f(yr[384 + lane]) : 0.f; const float p = __shfl_xor(x, 8);
          if (sample) { const int grp = (lane >> 3) & 3, i = lane & 7; const int pos = grp < 2 ? grow : gcol; const float c = R8[(pos * 8 + i) * 2], s = R8[(pos * 8 + i) * 2 + 1];
              x = (grp & 1) ? p * s + x * c : x * c - p * s; }
          if (lane < 32) { if (!sample) a.out[OUT_KR + (size_t)m * 32 + lane] = x; KR[(size_t)kvrow * 32 + lane] = (bf16)f2bf(x); } }
        const int s8 = lane & 7; const int pos16 = s8 < 4 ? grow : gcol; const int fi0 = (s8 & 1) * 8; const bool second = (s8 & 2) != 0;
        const float* cs = R16 + (pos16 * 16 + fi0) * 2;
        const int hb = lane >> 4; const size_t oo = ((size_t)(b * 4 + hb) * 256 + t) * 128 + (lane & 15) * 8;
        { u32x4 w = *(const u32x4*)(yr + 416 + 8 * lane); const u32x4 p = shfl_xor4(w, 2); if (sample) rope8(w, p, cs, second); *(u32x4*)(DQ + (size_t)m * 512 + 8 * lane) = w; }
        { u32x4 w = *(const u32x4*)(yr + 928 + 8 * lane); const u32x4 p = shfl_xor4(w, 2); if (sample) rope8(w, p, cs, second); else st_f32x8(a.out + OUT_DK + oo, w);
          *(u32x4*)(DK + (size_t)kvrow * 512 + 8 * lane) = w; }
        { const u32x4 w = *(const u32x4*)(yr + 1440 + 8 * lane); if (!sample) st_f32x8(a.out + OUT_DV + oo, w); *(u32x4*)(DV + (size_t)kvrow * 512 + 8 * lane) = w; }
    }
}

template <int D, int DV>
__device__ __forceinline__ void attn_pass(unsigned char* lds, const bf16x8 (&qf)[D / 16], const bf16* kA, int ldA, const bf16* kB, int ldB,
                                          const bf16* vS, int ldV, int nkeys, float csc, f32x16 (&o)[DV / 32]) {
    constexpr int KS = (D + 8) * 2, VS = 144, KP = D / 8, VP = DV / 8;
    unsigned char* Kl = lds; unsigned char* VT = lds + 64 * KS;
    const int tid = ltid(), lane = tid & 63, r32 = lane & 31, hi = lane >> 5;
    const int prow = (r32 & ~12) | (((r32 >> 2) & 1) << 3) | (((r32 >> 3) & 1) << 2);
    const int kkey0 = tid / KP, kdc0 = tid % KP, kkey1 = (tid + 512) / KP, kdc1 = (tid + 512) % KP;
    const bool k2 = (64 * KP > 512) && (tid + 512 < 64 * KP);
    const int vkey0 = tid / VP, vc0 = tid % VP;
    const bf16* ksrc0 = kdc0 < 8 ? kA + (size_t)kkey0 * ldA + kdc0 * 8 : kB + (size_t)kkey0 * ldB + (kdc0 - 8) * 8;
    const size_t kst0 = kdc0 < 8 ? (size_t)64 * ldA : (size_t)64 * ldB;
    const bf16* ksrc1 = kdc1 < 8 ? kA + (size_t)kkey1 * ldA + kdc1 * 8 : kB + (size_t)kkey1 * ldB + (kdc1 - 8) * 8;
    const size_t kst1 = kdc1 < 8 ? (size_t)64 * ldA : (size_t)64 * ldB;
    const bf16* vsrc0 = vS + (size_t)vkey0 * ldV + vc0 * 8;
    const bf16* vsrc1 = vsrc0 + (size_t)(512 / VP) * ldV;
    const size_t vst = (size_t)64 * ldV;
    u32x4 kr0, kr1 = {0u, 0u, 0u, 0u}, vr0, vr1 = {0u, 0u, 0u, 0u};
#define ATT_LOAD(t) do { kr0 = *(const u32x4*)(ksrc0 + (t) * kst0); if (k2) kr1 = *(const u32x4*)(ksrc1 + (t) * kst1); \
        vr0 = *(const u32x4*)(vsrc0 + (t) * vst); if (VP == 16) vr1 = *(const u32x4*)(vsrc1 + (t) * vst); } while (0)
#define ATT_VTW(reg, key, c) do { bf16* vt_ = (bf16*)VT + (size_t)((c) * 8) * 72 + (key); \
        vt_[0] = (bf16)(reg.x & 0xffffu); vt_[72] = (bf16)(reg.x >> 16); vt_[144] = (bf16)(reg.y & 0xffffu); vt_[216] = (bf16)(reg.y >> 16); \
        vt_[288] = (bf16)(reg.z & 0xffffu); vt_[360] = (bf16)(reg.z >> 16); vt_[432] = (bf16)(reg.w & 0xffffu); vt_[504] = (bf16)(reg.w >> 16); } while (0)
    float mrun = -1e30f, lsum = 0.f;
#pragma unroll
    for (int i = 0; i < DV / 32; ++i)
#pragma unroll
        for (int r = 0; r < 16; ++r) o[i][r] = 0.f;
    const int NT = nkeys >> 6;
    ATT_LOAD(0);
    for (int t = 0; t < NT; ++t) {
        *(u32x4*)(Kl + kkey0 * KS + kdc0 * 16) = kr0;
        if (k2) *(u32x4*)(Kl + kkey1 * KS + kdc1 * 16) = kr1;
        ATT_VTW(vr0, vkey0, vc0);
        if (VP == 16) ATT_VTW(vr1, vkey0 + 32, vc0);
        __syncthreads();
        if (t + 1 < NT) ATT_LOAD(t + 1);
        f32x16 s0, s1;
#pragma unroll
        for (int r = 0; r < 16; ++r) { s0[r] = 0.f; s1[r] = 0.f; }
#pragma unroll
        for (int dc = 0; dc < D / 16; ++dc) {
            const bf16x8 k0 = *(const bf16x8*)(Kl + prow * KS + (dc * 16 + hi * 8) * 2);
            const bf16x8 k1 = *(const bf16x8*)(Kl + (32 + prow) * KS + (dc * 16 + hi * 8) * 2);
            s0 = mfma32(k0, qf[dc], s0); s1 = mfma32(k1, qf[dc], s1);
        }
        float mx = -1e30f;
#pragma unroll
        for (int r = 0; r < 16; ++r) mx = fmaxf(mx, fmaxf(s0[r], s1[r]));
        mx *= csc; mx = fmaxf(mx, __shfl_xor(mx, 32));
        const float mn = fmaxf(mrun, mx); const float alpha = __builtin_amdgcn_exp2f(mrun - mn); mrun = mn;
        lsum *= alpha;
#pragma unroll
        for (int i = 0; i < DV / 32; ++i)
#pragma unroll
            for (int r = 0; r < 16; ++r) o[i][r] *= alpha;
#pragma unroll
        for (int r = 0; r < 16; ++r) { s0[r] = __builtin_amdgcn_exp2f(s0[r] * csc - mn); s1[r] = __builtin_amdgcn_exp2f(s1[r] * csc - mn); lsum += s0[r] + s1[r]; }
        bf16x8 pf[4];
        pf[0] = pack8(s0[0], s0[1], s0[2], s0[3], s0[4], s0[5], s0[6], s0[7]); pf[1] = pack8(s0[8], s0[9], s0[10], s0[11], s0[12], s0[13], s0[14], s0[15]);
        pf[2] = pack8(s1[0], s1[1], s1[2], s1[3], s1[4], s1[5], s1[6], s1[7]); pf[3] = pack8(s1[8], s1[9], s1[10], s1[11], s1[12], s1[13], s1[14], s1[15]);
#pragma unroll
        for (int dvt = 0; dvt < DV / 32; ++dvt)
#pragma unroll
            for (int kc = 0; kc < 4; ++kc) {
                const bf16x8 v = *(const bf16x8*)(VT + (dvt * 32 + r32) * VS + (16 * kc + 8 * hi) * 2);
                o[dvt] = mfma32(v, pf[kc], o[dvt]);
            }
        __syncthreads();
    }
#undef ATT_LOAD
#undef ATT_VTW
    lsum += __shfl_xor(lsum, 32);
    const float inv = 1.f / lsum;
#pragma unroll
    for (int i = 0; i < DV / 32; ++i)
#pragma unroll
        for (int r = 0; r < 16; ++r) o[i][r] *= inv;
}

__device__ __forceinline__ void attn_mla_unit(const Args& a, unsigned char* lds, bool isS, int b, int h, int qb) {
    unsigned char* ws = a.ws;
    const int tid = ltid(), lane = tid & 63, wave = tid >> 6, r32 = lane & 31, hi = lane >> 5;
    const bf16* QA = (const bf16*)(ws + WS_QA); const bf16* KVA = (const bf16*)(ws + WS_KVA); const bf16* KR = (const bf16*)(ws + WS_KR);
    bf16* MG = (bf16*)(ws + WS_MERGED);
    const int tq = qb * 256 + wave * 32 + r32;
    const int mq = isS ? NPROMPT + b * 1024 + tq : b * 256 + tq;
    const int kvrow0 = isS ? NPROMPT + b * 1280 : b * 256, nkeys = isS ? 1280 : 256;
    const bf16* qp = QA + (size_t)mq * 768 + h * 96;
    bf16x8 qf[6];
#pragma unroll
    for (int dc = 0; dc < 4; ++dc) qf[dc] = *(const bf16x8*)(qp + dc * 16 + hi * 8);
    if (isS) {
        const float* R8 = (const float*)(ws + WS_ROPE8);
#pragma unroll
        for (int dc = 4; dc < 6; ++dc) {
            u32x4 x1 = *(const u32x4*)(qp + dc * 16), x2 = *(const u32x4*)(qp + dc * 16 + 8);
            const int pos = dc == 4 ? (tq >> 6) : (tq & 63);
            if (hi) { u32x4 tmp = x2; rope8(tmp, x1, R8 + pos * 16, true); qf[dc] = __builtin_bit_cast(bf16x8, tmp); }
            else { u32x4 tmp = x1; rope8(tmp, x2, R8 + pos * 16, false); qf[dc] = __builtin_bit_cast(bf16x8, tmp); }
        }
    } else {
        qf[4] = *(const bf16x8*)(qp + 64 + hi * 8); qf[5] = *(const bf16x8*)(qp + 80 + hi * 8);
    }
    f32x16 o[2];
    const float csc = 0.10206207261596575f * 1.4426950408889634f;
    attn_pass<96, 64>(lds, qf, KVA + (size_t)kvrow0 * 1024 + h * 128, 1024, KR + (size_t)kvrow0 * 32, 32, KVA + (size_t)kvrow0 * 1024 + h * 128 + 64, 1024, nkeys, csc, o);
    bf16* op = MG + (size_t)mq * 1024 + h * 64 + 4 * hi;
#pragma unroll
    for (int dvt = 0; dvt < 2; ++dvt)
#pragma unroll
        for (int g = 0; g < 4; ++g) { u32x2 w; w.x = pk2(o[dvt][4 * g], o[dvt][4 * g + 1]); w.y = pk2(o[dvt][4 * g + 2], o[dvt][4 * g + 3]); *(u32x2*)(op + dvt * 32 + g * 8) = w; }
}

__device__ __forceinline__ void attn_diff_unit(const Args& a, unsigned char* lds, bool isS, int b, int hb, int qb, float lam) {
    unsigned char* ws = a.ws;
    const int tid = ltid(), lane = tid & 63, wave = tid >> 6, r32 = lane & 31, hi = lane >> 5;
    const bf16* DQ = (const bf16*)(ws + WS_DQ); const bf16* DK = (const bf16*)(ws + WS_DK); const bf16* DV = (const bf16*)(ws + WS_DV);
    bf16* MG = (bf16*)(ws + WS_MERGED);
    const int tq = qb * 256 + wave * 32 + r32;
    const int mq = isS ? NPROMPT + b * 1024 + tq : b * 256 + tq;
    const int kvrow0 = isS ? NPROMPT + b * 1280 : b * 256, nkeys = isS ? 1280 : 256;
    const float csc = 0.125f * 1.4426950408889634f;
    unsigned o1p[4][8];
    f32x16 o[4];
#pragma unroll 1
    for (int sub = 0; sub < 2; ++sub) {
        const bf16* qp = DQ + (size_t)mq * 512 + hb * 128 + sub * 64;
        bf16x8 qf[4];
#pragma unroll
        for (int dc = 0; dc < 4; ++dc) qf[dc] = *(const bf16x8*)(qp + dc * 16 + hi * 8);
        attn_pass<64, 128>(lds, qf, DK + (size_t)kvrow0 * 512 + hb * 128 + sub * 64, 512, nullptr, 0, DV + (size_t)kvrow0 * 512 + hb * 128, 512, nkeys, csc, o);
        if (sub == 0) {
#pragma unroll
            for (int i = 0; i < 4; ++i)
#pragma unroll
                for (int r = 0; r < 8; ++r) o1p[i][r] = pk2(o[i][2 * r], o[i][2 * r + 1]);
        }
    }
    float ss = 0.f;
#pragma unroll
    for (int i = 0; i < 4; ++i)
#pragma unroll
        for (int r = 0; r < 8; ++r) { const float d0 = bflo(o1p[i][r]) - lam * o[i][2 * r], d1 = bfhi(o1p[i][r]) - lam * o[i][2 * r + 1]; o[i][2 * r] = d0; o[i][2 * r + 1] = d1; ss += d0 * d0 + d1 * d1; }
    ss += __shfl_xor(ss, 32);
    const float rstd = rsqrtf(ss * (1.f / 128.f) + RMS_EPS) * 0.8f;
    const float* gs = a.in[23];
    bf16* op = MG + (size_t)mq * 1024 + 512 + hb * 128 + 4 * hi;
#pragma unroll
    for (int dvt = 0; dvt < 4; ++dvt)
#pragma unroll
        for (int g = 0; g < 4; ++g) {
            const f32x4 gv = *(const f32x4*)(gs + dvt * 32 + g * 8 + 4 * hi);
            u32x2 w; w.x = pk2(o[dvt][4 * g] * rstd * gv.x, o[dvt][4 * g + 1] * rstd * gv.y); w.y = pk2(o[dvt][4 * g + 2] * rstd * gv.z, o[dvt][4 * g + 3] * rstd * gv.w);
            *(u32x2*)(op + dvt * 32 + g * 8) = w;
        }
}

__device__ __forceinline__ void phase_attn(const Args& a, unsigned char* lds) {
    const int lane = ltid() & 63, G = gridDim.x;
    const float* lv = a.in[22];
    const float lam = expf(wave_sum(lv[lane] * lv[64 + lane])) - expf(wave_sum(lv[128 + lane] * lv[192 + lane])) + 0.2f;
    for (int Lx = lbid(); Lx < 1024; Lx += G) {
        const int s = Lx >> 8, i = Lx & 255;
        if (i < 128) {
            if (s == 0) attn_diff_unit(a, lds, true, i >> 4, (i >> 2) & 3, i & 3, lam);
            else if (s == 1) attn_mla_unit(a, lds, false, i >> 3, i & 7, 0);
        } else {
            const int j = i - 128;
            if (s < 2) { const int u = 2 * j + s; attn_mla_unit(a, lds, true, u >> 5, (u >> 2) & 7, u & 3); }
            else if (s == 2) attn_mla_unit(a, lds, false, i >> 3, i & 7, 0);
            else attn_diff_unit(a, lds, false, j >> 2, j & 3, 0, lam);
        }
    }
}

__device__ __forceinline__ void scan_unit(const Args& a, unsigned char* lds, bool isS, int b, int h, int dir) {
    unsigned char* ws = a.ws;
    const int tid = ltid(), lane = tid & 63, wave = tid >> 6, r32 = lane & 31, hi = lane >> 5;
    const bf16* Y2 = (const bf16*)(ws + WS_Y);
    bf16* CP = (bf16*)(a.out + OUT_Y); float* NP = (float*)(ws + WS_NP); float* MP = (float*)(ws + WS_MP);
    const float* bg = a.in[26];
    const int T = isS ? 1024 : 256, nc = isS ? 16 : 4, tok0 = isS ? NPROMPT + b * 1024 : b * 256;
    const int cpbase = isS ? 2048 + ((b * 8 + h) * 2 + dir) * 16 : ((b * 8 + h) * 2 + dir) * 4;
    bf16* kT = (bf16*)lds; bf16* vT = kT + 64 * 72; float* sW = (float*)(vT + 128 * 72); float* sSc = sW + 64;
    const int dt = wave & 1, et = wave >> 1;
    f32x16 C; float nst = 0.f, mst = 0.f;
#pragma unroll
    for (int r = 0; r < 16; ++r) C[r] = 0.f;
    if (isS) {
        const size_t sb = (size_t)((b * 2 + dir) * 8 + h);
        const float* C0 = a.in[6] + sb * 8192;
#pragma unroll
        for (int r = 0; r < 16; ++r) C[r] = C0[(size_t)(32 * dt + (r & 3) + 8 * (r >> 2) + 4 * hi) * 128 + 32 * et + r32];
        nst = a.in[7][sb * 64 + lane]; mst = a.in[8][sb];
    }
    const float bgi = bg[(2 * dir) * 8 + h], bgf = bg[(2 * dir + 1) * 8 + h];
    for (int c = 0; c < nc; ++c) {
        if (wave == 0) {
            const int tok = tok0 + (dir ? T - 1 - (64 * c + lane) : 64 * c + lane);
            const bf16* yr = Y2 + (size_t)tok * 3328 + 3072;
            const float gi = bf2f(yr[(2 * dir) * 8 + h]) + bgi, gf = bf2f(yr[(2 * dir + 1) * 8 + h]) + bgf;
            const float lf = log_sigmoid(gf);
            const float bc = scan_sum(lf, lane); const float g = __shfl(bc, 63);
            const float aa = g - bc + gi; const float amax = wave_max(aa);
            sW[lane] = expf(aa - amax) * 0.125f;
            if (lane == 0) { sSc[0] = g; sSc[1] = amax; }
        }
        __syncthreads();
        const float g = sSc[0], amax = sSc[1];
        {
            const int j = tid >> 3, dc = tid & 7; const int tok = tok0 + (dir ? T - 1 - (64 * c + j) : 64 * c + j);
            const u32x4 kw = *(const u32x4*)(Y2 + (size_t)tok * 3328 + 512 + h * 64 + dc * 8); const float wj = sW[j];
            bf16* kp = kT + (dc * 8) * 72 + j;
            kp[0] = (bf16)f2bf(bflo(kw.x) * wj); kp[72] = (bf16)f2bf(bfhi(kw.x) * wj); kp[144] = (bf16)f2bf(bflo(kw.y) * wj); kp[216] = (bf16)f2bf(bfhi(kw.y) * wj);
            kp[288] = (bf16)f2bf(bflo(kw.z) * wj); kp[360] = (bf16)f2bf(bfhi(kw.z) * wj); kp[432] = (bf16)f2bf(bflo(kw.w) * wj); kp[504] = (bf16)f2bf(bfhi(kw.w) * wj);
#pragma unroll
            for (int q = 0; q < 2; ++q) {
                const int p = tid + q * 512, jv = p >> 4, cc = p & 15; const int tokv = tok0 + (dir ? T - 1 - (64 * c + jv) : 64 * c + jv);
                const u32x4 vw = *(const u32x4*)(Y2 + (size_t)tokv * 3328 + 1024 + h * 128 + cc * 8);
                bf16* vp = vT + (cc * 8) * 72 + jv;
                vp[0] = (bf16)(vw.x & 0xffffu); vp[72] = (bf16)(vw.x >> 16); vp[144] = (bf16)(vw.y & 0xffffu); vp[216] = (bf16)(vw.y >> 16);
                vp[288] = (bf16)(vw.z & 0xffffu); vp[360] = (bf16)(vw.z >> 16); vp[432] = (bf16)(vw.w & 0xffffu); vp[504] = (bf16)(vw.w >> 16);
            }
        }
        __syncthreads();
        f32x16 kv;
#pragma unroll
        for (int r = 0; r < 16; ++r) kv[r] = 0.f;
#pragma unroll
        for (int lc = 0; lc < 4; ++lc) {
            const bf16x8 A = *(const bf16x8*)(kT + (32 * dt + r32) * 72 + 16 * lc + 8 * hi);
            const bf16x8 B = *(const bf16x8*)(vT + (32 * et + r32) * 72 + 16 * lc + 8 * hi);
            kv = mfma32(A, B, kv);
        }
        float kn = 0.f;
        if (wave == 0) {
#pragma unroll
            for (int q = 0; q < 8; ++q) { const u32x4 w = *(const u32x4*)(kT + lane * 72 + q * 8);
                kn += (bflo(w.x) + bfhi(w.x)) + (bflo(w.y) + bfhi(w.y)) + (bflo(w.z) + bfhi(w.z)) + (bflo(w.w) + bfhi(w.w)); }
        }
        const int cpi = cpbase + c;
        bf16* cp = CP + (size_t)cpi * 8192 + (size_t)(32 * et + r32) * 64 + 32 * dt + 4 * hi;
#pragma unroll
        for (int g4 = 0; g4 < 4; ++g4) { u32x2 w; w.x = pk2(C[4 * g4], C[4 * g4 + 1]); w.y = pk2(C[4 * g4 + 2], C[4 * g4 + 3]); *(u32x2*)(cp + 8 * g4) = w; }
        if (wave == 0) { NP[(size_t)cpi * 64 + lane] = nst; if (lane == 0) MP[cpi] = mst; }
        const float mnew = fmaxf(g + mst, amax); const float so = expf(g + mst - mnew), sn = expf(amax - mnew);
#pragma unroll
        for (int r = 0; r < 16; ++r) C[r] = so * C[r] + sn * kv[r];
        nst = so * nst + sn * kn; mst = mnew;
        __syncthreads();
    }
    if (!isS) {
        const size_t sb = (size_t)((b * 2 + dir) * 8 + h);
        float* Co = a.out + OUT_C + sb * 8192;
#pragma unroll
        for (int r = 0; r < 16; ++r) Co[(size_t)(32 * dt + (r & 3) + 8 * (r >> 2) + 4 * hi) * 128 + 32 * et + r32] = C[r];
        if (wave == 0) { a.out[OUT_N + sb * 64 + lane] = nst; if (lane == 0) a.out[OUT_M + sb] = mst; }
    }
}
__device__ __forceinline__ void phase_scan(const Args& a, unsigned char* lds) {
    const int G = gridDim.x;
    for (int Lx = lbid(); Lx < 1024; Lx += G) {
        const int s = Lx >> 8, i = Lx & 255;
        if (i < 128) { if (s == 0) scan_unit(a, lds, true, i >> 4, (i >> 1) & 7, i & 1); }
        else { const int v = (i - 128) * 4 + s; scan_unit(a, lds, false, v >> 4, (v >> 1) & 7, v & 1); }
    }
}

__device__ __forceinline__ void intra_unit(const Args& a, unsigned char* lds, bool isS, int b, int h, int c) {
    unsigned char* ws = a.ws;
    const int tid = ltid(), lane = tid & 63, wave = tid >> 6, r32 = lane & 31, hi = lane >> 5;
    const bf16* Y2 = (const bf16*)(ws + WS_Y);
    const bf16* CP = (const bf16*)(a.out + OUT_Y); const float* NP = (const float*)(ws + WS_NP); const float* MP = (const float*)(ws + WS_MP);
    bf16* HS = (bf16*)(ws + WS_HS);
    const float* bg = a.in[26];
    const int nc = isS ? 16 : 4, tok0 = (isS ? NPROMPT + b * 1024 : b * 256) + 64 * c;
    const int cpb = isS ? 2048 + ((b * 8 + h) * 2) * 16 : ((b * 8 + h) * 2) * 4;
    bf16* sQ = (bf16*)lds; bf16* sK = sQ + 64 * 72; bf16* sVT = sK + 64 * 72;
    float* sB = (float*)(sVT + 128 * 72); float* sU = sB + 128; float* sMT = sU + 128; float* sNP = sMT + 128; float* sMp = sNP + 128; float* sRed = sMp + 2;
    {
        const int l = tid >> 3, dc = tid & 7; const bf16* yr = Y2 + (size_t)(tok0 + l) * 3328 + h * 64 + dc * 8;
        *(u32x4*)(sQ + l * 72 + dc * 8) = *(const u32x4*)yr;
        const u32x4 kw = *(const u32x4*)(yr + 512);
        u32x4 ks; ks.x = pk2(bflo(kw.x) * 0.125f, bfhi(kw.x) * 0.125f); ks.y = pk2(bflo(kw.y) * 0.125f, bfhi(kw.y) * 0.125f);
        ks.z = pk2(bflo(kw.z) * 0.125f, bfhi(kw.z) * 0.125f); ks.w = pk2(bflo(kw.w) * 0.125f, bfhi(kw.w) * 0.125f);
        *(u32x4*)(sK + l * 72 + dc * 8) = ks;
#pragma unroll
        for (int q = 0; q < 2; ++q) {
            const int p = tid + q * 512, lv = p >> 4, cc = p & 15;
            const u32x4 vw = *(const u32x4*)(Y2 + (size_t)(tok0 + lv) * 3328 + 1024 + h * 128 + cc * 8);
            bf16* vp = sVT + (cc * 8) * 72 + lv;
            vp[0] = (bf16)(vw.x & 0xffffu); vp[72] = (bf16)(vw.x >> 16); vp[144] = (bf16)(vw.y & 0xffffu); vp[216] = (bf16)(vw.y >> 16);
            vp[288] = (bf16)(vw.z & 0xffffu); vp[360] = (bf16)(vw.z >> 16); vp[432] = (bf16)(vw.w & 0xffffu); vp[504] = (bf16)(vw.w >> 16);
        }
    }
    if (wave < 2) {
        const int dir = wave; const int l = dir ? 63 - lane : lane;
        const int cpi = cpb + dir * nc + (dir ? nc - 1 - c : c);
        const bf16* yr = Y2 + (size_t)(tok0 + l) * 3328 + 3072;
        const float gi = bf2f(yr[(2 * dir) * 8 + h]) + bg[(2 * dir) * 8 + h], gf = bf2f(yr[(2 * dir + 1) * 8 + h]) + bg[(2 * dir + 1) * 8 + h];
        const float bc = scan_sum(log_sigmoid(gf), lane);
        const float u = gi - bc; const float mx = scan_max(u, lane);
        const float mp = MP[cpi];
        sB[dir * 64 + l] = bc; sU[dir * 64 + l] = u; sMT[dir * 64 + l] = bc + fmaxf(mp, mx);
        sNP[dir * 64 + lane] = NP[(size_t)cpi * 64 + lane];
        if (lane == 0) sMp[dir] = mp;
    }
    __syncthreads();
    const int lt = wave & 1, et = wave >> 1, l = 32 * lt + r32;
    const int prow = (r32 & ~12) | (((r32 >> 2) & 1) << 3) | (((r32 >> 3) & 1) << 2);
    bf16x8 qf[4];
#pragma unroll
    for (int dc = 0; dc < 4; ++dc) qf[dc] = *(const bf16x8*)(sQ + l * 72 + 16 * dc + 8 * hi);
    f32x16 hsum;
#pragma unroll
    for (int r = 0; r < 16; ++r) hsum[r] = 0.f;
#pragma unroll 1
    for (int dir = 0; dir < 2; ++dir) {
        const int cpi = cpb + dir * nc + (dir ? nc - 1 - c : c);
        f32x16 s0, s1, nacc, iacc;
#pragma unroll
        for (int r = 0; r < 16; ++r) { s0[r] = 0.f; s1[r] = 0.f; nacc[r] = 0.f; iacc[r] = 0.f; }
#pragma unroll
        for (int dc = 0; dc < 4; ++dc) {
            const bf16x8 k0 = *(const bf16x8*)(sK + prow * 72 + 16 * dc + 8 * hi);
            const bf16x8 k1 = *(const bf16x8*)(sK + (32 + prow) * 72 + 16 * dc + 8 * hi);
            s0 = mfma32(k0, qf[dc], s0); s1 = mfma32(k1, qf[dc], s1);
        }
        const bf16* cp = CP + (size_t)cpi * 8192 + (size_t)(32 * et + r32) * 64 + 8 * hi;
#pragma unroll
        for (int dc = 0; dc < 4; ++dc) { const bf16x8 cf = *(const bf16x8*)(cp + 16 * dc); iacc = mfma32(cf, qf[dc], iacc); }
        const float bl = sB[dir * 64 + l], mtl = sMT[dir * 64 + l], mp = sMp[dir];
        const float base = bl - mtl;
        float dsum = 0.f;
#pragma unroll
        for (int r = 0; r < 16; ++r) {
            const int si0 = 16 * (r >> 3) + 8 * hi + (r & 7), si1 = 32 + si0;
            const bool ok0 = dir ? (si0 >= l) : (si0 <= l), ok1 = dir ? (si1 >= l) : (si1 <= l);
            const float e0 = __expf(base + sU[dir * 64 + si0]), e1 = __expf(base + sU[dir * 64 + si1]);
            s0[r] = ok0 ? s0[r] * e0 : 0.f; s1[r] = ok1 ? s1[r] * e1 : 0.f; dsum += s0[r] + s1[r];
        }
        bf16x8 pf[4];
        pf[0] = pack8(s0[0], s0[1], s0[2], s0[3], s0[4], s0[5], s0[6], s0[7]); pf[1] = pack8(s0[8], s0[9], s0[10], s0[11], s0[12], s0[13], s0[14], s0[15]);
        pf[2] = pack8(s1[0], s1[1], s1[2], s1[3], s1[4], s1[5], s1[6], s1[7]); pf[3] = pack8(s1[8], s1[9], s1[10], s1[11], s1[12], s1[13], s1[14], s1[15]);
#pragma unroll
        for (int kc = 0; kc < 4; ++kc) { const bf16x8 v = *(const bf16x8*)(sVT + (32 * et + r32) * 72 + 16 * kc + 8 * hi); nacc = mfma32(v, pf[kc], nacc); }
        float qn = 0.f;
#pragma unroll
        for (int q = 0; q < 4; ++q) {
            const u32x4 w = *(const u32x4*)(sQ + l * 72 + 32 * hi + 8 * q); const float* np = sNP + dir * 64 + 32 * hi + 8 * q;
            qn += bflo(w.x) * np[0] + bfhi(w.x) * np[1] + bflo(w.y) * np[2] + bfhi(w.y) * np[3] + bflo(w.z) * np[4] + bfhi(w.z) * np[5] + bflo(w.w) * np[6] + bfhi(w.w) * np[7];
        }
        qn += __shfl_xor(qn, 32); dsum += __shfl_xor(dsum, 32);
        const float inter = expf(bl + mp - mtl);
        const float den = dsum + inter * qn;
        const float inv = 1.f / fmaxf(fabsf(den), expf(-mtl));
#pragma unroll
        for (int r = 0; r < 16; ++r) hsum[r] += (nacc[r] + inter * iacc[r]) * inv;
    }
    float ss = 0.f;
#pragma unroll
    for (int r = 0; r < 16; ++r) ss += hsum[r] * hsum[r];
    ss += __shfl_xor(ss, 32);
    if (hi == 0) sRed[et * 64 + l] = ss;
    __syncthreads();
    const float tot = (sRed[l] + sRed[64 + l]) + (sRed[128 + l] + sRed[192 + l]);
    const float rstd = rsqrtf(tot * (1.f / 128.f) + RMS_EPS);
    const float* gn = a.in[27];
    const bf16* orow = Y2 + (size_t)(tok0 + l) * 3328 + 2048 + h * 128 + 32 * et + 4 * hi;
    bf16* hrow = HS + (size_t)(tok0 + l) * 1024 + h * 128 + 32 * et + 4 * hi;
#pragma unroll
    for (int g4 = 0; g4 < 4; ++g4) {
        const u32x2 ow = *(const u32x2*)(orow + 8 * g4); const f32x4 gv = *(const f32x4*)(gn + 32 * et + 4 * hi + 8 * g4);
        const float o0 = bflo(ow.x), o1 = bfhi(ow.x), o2 = bflo(ow.y), o3 = bfhi(ow.y);
        u32x2 w;
        w.x = pk2(hsum[4 * g4] * rstd * gv.x / (1.f + __expf(-o0)), hsum[4 * g4 + 1] * rstd * gv.y / (1.f + __expf(-o1)));
        w.y = pk2(hsum[4 * g4 + 2] * rstd * gv.z / (1.f + __expf(-o2)), hsum[4 * g4 + 3] * rstd * gv.w / (1.f + __expf(-o3)));
        *(u32x2*)(hrow + 8 * g4) = w;
    }
    __syncthreads();
}
__device__ __forceinline__ void phase_intra(const Args& a, unsigned char* lds) {
    const int G = gridDim.x;
    for (int U = lbid(); U < 2048; U += G) {
        if (U < 1024) intra_unit(a, lds, false, U >> 5, (U >> 2) & 7, U & 3);
        else { const int v = U - 1024; intra_unit(a, lds, true, v >> 7, (v >> 4) & 7, v & 15); }
    }
}

template <int M, int N, int K, class Epi>
__device__ __forceinline__ void run_gemm(unsigned char* lds, const bf16* A, const bf16* Bt, const Epi& E) {
    pg8::Gemm g{A, Bt, M, N, K}; pg8::StaticOrder S; S.init(M, N, (int)gridDim.x, lbid());
    pg8::gemm_phase<Epi, pg8::StaticOrder, true, true>((PG8_LAS unsigned char*)lds, g, S, E);
}
template <int N, int K>
__device__ __forceinline__ void gemm_plain(unsigned char* lds, unsigned char* ws, size_t offA, size_t offB, size_t offO, int dummy) {
    pg8::EpiBf16<0> E{(bf16*)(ws + offO), N, nullptr, 0, 0, 1.f};
    run_gemm<MTOK, N, K>(lds, (const bf16*)(ws + offA), (const bf16*)(ws + offB), E);
}
template <int K>
__device__ __forceinline__ void gemm_gate(const Args& a, unsigned char* lds, unsigned char* ws, size_t offA, size_t offB, bool fromInput, int L, int goff) {
    float* X = (float*)(ws + WS_X);
    EpiGate E{fromInput ? a.in[0] : X, fromInput ? a.in[1] : X + (size_t)NPROMPT * 1024, X, (const float*)(ws + WS_MOD) + (size_t)L * 9 * 6144 + goff};
    run_gemm<MTOK, 1024, K>(lds, (const bf16*)(ws + offA), (const bf16*)(ws + offB), E);
}

__global__ void __launch_bounds__(NTHREADS, 2) fwd_kernel(Args a) {
    extern __shared__ __attribute__((aligned(16))) unsigned char lds[];
    const int lo = a.ph_lo, hi = a.ph_hi;
#define PHASE(k, ...) if (lo <= (k) && (k) < hi) { unsigned char* ws = a.ws; asm volatile("" : "+s"(ws)); __VA_ARGS__; if ((k) + 1 < hi) cg::this_grid().sync(); }
    PHASE(0, phase_prep(a, lds))
    PHASE(1, phase_rowwise(a, 1))
    PHASE(2, (gemm_plain<2048, 1024>(lds, ws, WS_H, WS_W_INAB, WS_Y, 0)))
    PHASE(3, phase_split(a))
    PHASE(4, { gemm_plain<768, 256>(lds, ws, WS_CQN, WS_W_UQ, WS_QA, 0);
               pg8::EpiBf16<0> E{(bf16*)(ws + WS_KVA), 1024, nullptr, 0, 0, 1.f};
               run_gemm<KVROWS, 1024, 256>(lds, (const bf16*)(ws + WS_CKVA), (const bf16*)(ws + WS_W_UKV), E); })
    PHASE(5, phase_attn(a, lds))
    PHASE(6, gemm_gate<1024>(a, lds, ws, WS_MERGED, WS_W_OUTAB, true, 0, 2048))
    PHASE(7, phase_rowwise(a, 7))
    PHASE(8, { EpiSwiGLU E{(bf16*)(ws + WS_HID)}; run_gemm<MTOK, 5632, 1024>(lds, (const bf16*)(ws + WS_H), (const bf16*)(ws + WS_W_FFI), E); })
    PHASE(9, gemm_gate<2816>(a, lds, ws, WS_HID, WS_W_FFO, false, 0, 5120))
    PHASE(10, phase_rowwise(a, 10))
    PHASE(11, (gemm_plain<3328, 1024>(lds, ws, WS_H, WS_W_INC, WS_Y, 0)))
    PHASE(12, phase_scan(a, lds))
    PHASE(13, phase_intra(a, lds))
    PHASE(14, gemm_gate<1024>(a, lds, ws, WS_HS, WS_W_OUTC, false, 1, 2048))
    PHASE(15, phase_rowwise(a, 15))
    PHASE(16, { EpiSwiGLU E{(bf16*)(ws + WS_HID)}; run_gemm<MTOK, 5632, 1024>(lds, (const bf16*)(ws + WS_H), (const bf16*)(ws + WS_W_FFI) + (size_t)5632 * 1024, E); })
    PHASE(17, gemm_gate<2816>(a, lds, ws, WS_HID, WS_W_FFO + (size_t)1024 * 2816 * 2, false, 1, 5120))
    PHASE(18, phase_rowwise(a, 18))
#undef PHASE
}

#ifndef MK_COOP
#define MK_COOP 1
#endif
constexpr int NPHASES = 19;
extern "C" void kernel_launch(void* const* d_in, const int* in_sizes, int n_in, void* d_out, int out_size, void* d_ws, size_t ws_size, hipStream_t stream) {
    static int grid = 0;
    if (grid == 0) {
        if (n_in != 30 || ws_size < WS_END) { fprintf(stderr, "kernel_launch: unexpected n_in %d / ws_size %zu\n", n_in, ws_size); grid = -1; return; }
        int dev = 0, cus = 0, per_cu = 0;
        hipGetDevice(&dev); hipDeviceGetAttribute(&cus, hipDeviceAttributeMultiprocessorCount, dev);
        if (hipFuncSetAttribute((const void*)fwd_kernel, hipFuncAttributeMaxDynamicSharedMemorySize, LDS_BYTES) != hipSuccess) { fprintf(stderr, "kernel_launch: hipFuncSetAttribute failed\n"); grid = -1; return; }
        if (hipOccupancyMaxActiveBlocksPerMultiprocessor(&per_cu, (const void*)fwd_kernel, NTHREADS, LDS_BYTES) != hipSuccess || per_cu < 1) per_cu = 1;
        (void)hipGetLastError();
        grid = cus * 1;
    }
    if (grid < 0) return;
    Args a{};
    for (int i = 0; i < 30; ++i) a.in[i] = (const float*)d_in[i];
    a.out = (float*)d_out; a.ws = (unsigned char*)d_ws;
#if MK_COOP
    a.ph_lo = 0; a.ph_hi = NPHASES;
    void* args[] = {&a};
    hipError_t e = hipLaunchCooperativeKernel((const void*)fwd_kernel, dim3(grid), dim3(NTHREADS), args, LDS_BYTES, stream);
    if (e != hipSuccess) fprintf(stderr, "cooperative launch failed: %s (grid %d)\n", hipGetErrorString(e), grid);
#else
    for (int ph = 0; ph < NPHASES; ++ph) {
        a.ph_lo = ph; a.ph_hi = ph + 1;
        hipLaunchKernelGGL(fwd_kernel, dim3(grid), dim3(NTHREADS), LDS_BYTES, stream, a);
    }
#endif
}
```

```cpp
#include <hip/hip_runtime.h>
#include <hip/hip_cooperative_groups.h>
#include <cstdio>
#include <cstdint>
namespace cg = cooperative_groups;
__device__ __forceinline__ int ltid() { int t = threadIdx.x; asm volatile("" : "+v"(t)); return t; }
__device__ __forceinline__ int lbid() { int b = blockIdx.x; asm volatile("" : "+s"(b)); return b; }
#define MK_COOP 1
namespace pg8 {
#define PG8_LAS __attribute__((address_space(3)))
typedef unsigned short bf16_t;
typedef short bf16x8 __attribute__((ext_vector_type(8)));
typedef float f32x4 __attribute__((ext_vector_type(4)));
typedef unsigned u32x4 __attribute__((ext_vector_type(4)));
constexpr int BM = 256, BK = 64, HALF = 128, HTB = HALF * BK * 2  , STAGE_BYTES = 8 * HTB, NXCD = 8, WGM = 8;

__host__ __device__ __forceinline__ int lds_byte(int r, int c) { const int st = (r >> 4) * 2 + (c >> 5), rr = r & 15, cc = c & 31, ob = rr * 64 + cc * 2; return st * 1024 + (ob ^ (((ob >> 9) & 1) << 5)); }
__host__ __device__ __forceinline__ void stage_rc(int b, int& R, int& C) { const int st = b / 1024, sb = b % 1024, swz = sb ^ (((sb >> 9) & 1) << 5); R = (st >> 1) * 16 + swz / 64; C = (st & 1) * 32 + (swz % 64) / 2; }
__host__ __device__ __forceinline__ int perm32(int rho) { const int n = rho >> 4, i = rho & 15; return 8 * (i >> 2) + 4 * n + (i & 3); }

struct Unit { int pm, pn; };
struct Gemm { const bf16_t* A; const bf16_t* Bt; int M, N, K; };

struct StaticOrder {
    int nM, nN, nwg, G, c;
    __host__ __device__ void init(int M, int N, int G_, int c_) { nM = M / BM; nN = N / BM; nwg = nM * nN; G = G_; c = c_; }
    __host__ __device__ bool next(int i, Unit& u) const {
        const long L = (long)i * G + c; if (L >= nwg) return false;
        int wgid = (int)L; { const int q = nwg / NXCD, r = nwg % NXCD, xcd = wgid % NXCD, off = wgid / NXCD; wgid = (xcd < r ? xcd * (q + 1) : r * (q + 1) + (xcd - r) * q) + off; }
        const int nig = WGM * nN, gid = wgid / nig, fm = gid * WGM, gsz = (nM - fm) < WGM ? (nM - fm) : WGM;
        u.pm = fm + ((wgid % nig) % gsz); u.pn = (wgid % nig) / gsz; return true;
    }
    __device__ __forceinline__ void a_ready(const Unit&) const {}
    __device__ __forceinline__ void done(const Unit&) const {}
};

__device__ __forceinline__ unsigned cvt_pk_bf16(float lo, float hi) { unsigned r; asm volatile("v_cvt_pk_bf16_f32 %0, %1, %2" : "=v"(r) : "v"(lo), "v"(hi)); return r; }
typedef float f32x2 __attribute__((ext_vector_type(2)));
__device__ __forceinline__ f32x2 gelu_pk(f32x2 v) {
    const f32x2 av = __builtin_elementwise_abs(v), d = av * 0.2316418882f + 1.0f;
    f32x2 t; t.x = __builtin_amdgcn_rcpf(d.x); t.y = __builtin_amdgcn_rcpf(d.y);
    f32x2 q = t * 0.5307027145f + (-0.7265760135f); q = q * t + 0.7107068705f; q = q * t + (-0.142248368f); q = q * t + 0.127414796f; q = q * t;
    const f32x2 s = (v * v) * (-0.72134752044f);
    f32x2 e; e.x = __builtin_amdgcn_exp2f(s.x); e.y = __builtin_amdgcn_exp2f(s.y);
    const f32x2 m = v * (q * e), r = v - m;
    f32x2 o; o.x = v.x < 0.f ? m.x : r.x; o.y = v.y < 0.f ? m.y : r.y; return o;
}

template <int ACT  > struct EpiBf16 {
    static constexpr bool PERM = true, AFTER_DRAIN = false; static_assert(ACT == 0 || ACT == 1, "EpiBf16: ACT is 0 (none) or 1 (gelu_pk)");
    bf16_t* O; int ldc; const float* bias; int split_cols; size_t split_stride; float scale0;
    __device__ __forceinline__ void operator()(const f32x4 (&acc)[2][2][4][2], const Unit& u, int wr, int wc, int fr, int fq) const {
        const int row0 = u.pm * BM + wr * 64 + fr; int colt = u.pn * BM; bf16_t* base = O;
        float sc = 1.f; if (split_cols) { const int t = colt / split_cols; base += (size_t)t * split_stride; colt -= t * split_cols; if (t == 0) sc = scale0; }
        const int col0 = colt + wc * 32 + 8 * fq, bcol0 = u.pn * BM + wc * 32 + 8 * fq;
        f32x4 bv[2][2];
#pragma unroll
        for (int bj = 0; bj < 2; ++bj)
#pragma unroll
            for (int n = 0; n < 2; ++n) bv[bj][n] = bias ? *(const f32x4*)(bias + bcol0 + bj * HALF + 4 * n) : (f32x4){0.f, 0.f, 0.f, 0.f};
#pragma unroll
        for (int ai = 0; ai < 2; ++ai)
#pragma unroll
            for (int m = 0; m < 4; ++m) { bf16_t* rowp = base + (size_t)(row0 + ai * HALF + m * 16) * ldc + col0;
#pragma unroll
                for (int bj = 0; bj < 2; ++bj) { f32x4 v0 = acc[ai][bj][m][0] + bv[bj][0], v1 = acc[ai][bj][m][1] + bv[bj][1];
                    if (ACT == 1) { f32x2 a = gelu_pk((f32x2){v0[0], v0[1]}), b = gelu_pk((f32x2){v0[2], v0[3]}), c = gelu_pk((f32x2){v1[0], v1[1]}), d = gelu_pk((f32x2){v1[2], v1[3]});
                        v0 = (f32x4){a.x, a.y, b.x, b.y}; v1 = (f32x4){c.x, c.y, d.x, d.y}; }
                    v0 = v0 * sc; v1 = v1 * sc; u32x4 w; w.x = cvt_pk_bf16(v0[0], v0[1]); w.y = cvt_pk_bf16(v0[2], v0[3]); w.z = cvt_pk_bf16(v1[0], v1[1]); w.w = cvt_pk_bf16(v1[2], v1[3]);
                    *(u32x4*)(rowp + bj * HALF) = w; } }
    }
};
template <class Epi, class Sched, bool ALIGN_EPI = false, bool SP2 = false>
__device__ __forceinline__ void gemm_phase(PG8_LAS unsigned char* lds, const Gemm g, const Sched& S, const Epi& E) {
    const int tid = ltid(), wid = __builtin_amdgcn_readfirstlane(tid >> 6), lane = tid & 63, wr = wid >> 2, wc = wid & 3, fr = lane & 15, fq = lane >> 4;
    const int K = g.K, nt = K / BK;
    unsigned voffA[2], voffB[2];
#pragma unroll
    for (int i = 0; i < 2; ++i) { int R, C; stage_rc(tid * 16 + i * 8192, R, C); const int Rb = Epi::PERM ? ((R & ~31) + perm32(R & 31)) : R;
        voffA[i] = (unsigned)(R * K + C) * 2u; voffB[i] = (unsigned)(Rb * K + C) * 2u; }
    const size_t kstep = (size_t)(BK * 2);
    const size_t hstep = (size_t)HALF * K * 2;
    const size_t tstep = 2 * hstep;
    const unsigned ldsw = (unsigned)wid * 1024u;
    const int aoff = lds_byte(wr * 64 + fr, fq * 8), boff = lds_byte(wc * 32 + fr, fq * 8);
#define PG8_SA(b, h) (((b) * 2 + (h)) * HTB)
#define PG8_SB(b, h) ((4 + (b) * 2 + (h)) * HTB)
#define PG8_STAGE(bufoff, gbase, voff) do { _Pragma("unroll") for (int _i = 0; _i < 2; ++_i) \
        __builtin_amdgcn_global_load_lds((const unsigned*)((const char*)(gbase) + (voff)[_i]), (PG8_LAS unsigned*)(lds + (bufoff) + ldsw + _i * 8192), 16, 0, 0); } while (0)
#define PG8_LDA(dst, b, h) do { _Pragma("unroll") for (int m = 0; m < 4; ++m) _Pragma("unroll") for (int k = 0; k < 2; ++k) dst[m][k] = *(const PG8_LAS bf16x8*)(lds + PG8_SA(b, h) + aoff + m * 2048 + k * 1024); } while (0)
#define PG8_LDB(dst, b, h) do { _Pragma("unroll") for (int n = 0; n < 2; ++n) _Pragma("unroll") for (int k = 0; k < 2; ++k) dst[n][k] = *(const PG8_LAS bf16x8*)(lds + PG8_SB(b, h) + boff + n * 2048 + k * 1024); } while (0)
#define PG8_MMA(ai, bj, At, Bt) do { __builtin_amdgcn_s_setprio(1); _Pragma("unroll") for (int m = 0; m < 4; ++m) _Pragma("unroll") for (int n = 0; n < 2; ++n) _Pragma("unroll") for (int k = 0; k < 2; ++k) \
        acc[ai][bj][m][n] = __builtin_amdgcn_mfma_f32_16x16x32_bf16(Bt[n][k], At[m][k], acc[ai][bj][m][n], 0, 0, 0); __builtin_amdgcn_s_setprio(0); } while (0)
#define PG8_WAIT_V(n) asm volatile("s_waitcnt vmcnt(" #n ")" ::: "memory")
#define PG8_WAIT_L(n) asm volatile("s_waitcnt lgkmcnt(" #n ")" ::: "memory")
#define PG8_BAR __builtin_amdgcn_s_barrier()
#define PG8_SCHED __builtin_amdgcn_sched_barrier(0)
    Unit cur, nxt; int ui = 0;
    if (!S.next(0, cur)) return;
    f32x4 acc[2][2][4][2];
#pragma unroll
    for (int a = 0; a < 2; ++a)
#pragma unroll
        for (int b = 0; b < 2; ++b)
#pragma unroll
            for (int m = 0; m < 4; ++m)
#pragma unroll
                for (int n = 0; n < 2; ++n) acc[a][b][m][n] = (f32x4){0.f, 0.f, 0.f, 0.f};
    bf16x8 At[4][2], B0[2][2], B1[2][2];
    const char* cA = (const char*)g.A + (size_t)cur.pm * tstep; const char* cB = (const char*)g.Bt + (size_t)cur.pn * tstep;
    S.a_ready(cur);
    if constexpr (SP2) {
        PG8_STAGE(PG8_SB(0, 0), cB, voffB); PG8_STAGE(PG8_SB(0, 1), cB + hstep, voffB); PG8_STAGE(PG8_SA(0, 0), cA, voffA); PG8_STAGE(PG8_SA(0, 1), cA + hstep, voffA);
        if (wr == 1) PG8_BAR;
        PG8_WAIT_V(2); PG8_BAR;
        PG8_STAGE(PG8_SB(1, 0), cB + kstep, voffB); PG8_STAGE(PG8_SA(1, 0), cA + kstep, voffA); PG8_STAGE(PG8_SB(1, 1), cB + hstep + kstep, voffB);
        PG8_WAIT_V(6); PG8_BAR;
    } else {
        PG8_STAGE(PG8_SB(0, 0), cB, voffB); PG8_STAGE(PG8_SA(0, 0), cA, voffA); PG8_STAGE(PG8_SB(0, 1), cB + hstep, voffB); PG8_STAGE(PG8_SA(0, 1), cA + hstep, voffA);
        if (wr == 1) PG8_BAR;
        PG8_WAIT_V(4); PG8_BAR;
        PG8_STAGE(PG8_SB(1, 0), cB + kstep, voffB); PG8_STAGE(PG8_SA(1, 0), cA + kstep, voffA); PG8_STAGE(PG8_SB(1, 1), cB + hstep + kstep, voffB);
        PG8_WAIT_V(6); PG8_BAR;
    }
    for (;;) {
        const bool has_next = S.next(ui + 1, nxt);
        const char* nA = has_next ? (const char*)g.A + (size_t)nxt.pm * tstep : cA; const char* nB = has_next ? (const char*)g.Bt + (size_t)nxt.pn * tstep : cB;
        for (int t = 0; t < nt; t += 2) {
            const bool last = (t == nt - 2);
            const char* a1 = cA + (size_t)(t + 1) * kstep;
            const char* a2 = last ? nA : cA + (size_t)(t + 2) * kstep; const char* b2 = last ? nB : cB + (size_t)(t + 2) * kstep;
            const char* a3 = a2 + kstep; const char* b3 = b2 + kstep;
            if (last && has_next) S.a_ready(nxt);
            if constexpr (SP2) {
            PG8_LDB(B0, 0, 0); PG8_LDB(B1, 0, 1); PG8_SCHED; PG8_LDA(At, 0, 0); PG8_STAGE(PG8_SA(1, 1), a1 + hstep, voffA);
            PG8_WAIT_V(8); PG8_WAIT_L(0); PG8_BAR; PG8_MMA(0, 0, At, B0); PG8_MMA(0, 1, At, B1); PG8_BAR; PG8_SCHED;
            PG8_LDA(At, 0, 1); PG8_STAGE(PG8_SB(0, 0), b2, voffB); PG8_STAGE(PG8_SB(0, 1), b2 + hstep, voffB); PG8_STAGE(PG8_SA(0, 0), a2, voffA);
            PG8_WAIT_V(8); PG8_WAIT_L(0); PG8_BAR; PG8_MMA(1, 0, At, B0); PG8_MMA(1, 1, At, B1); PG8_BAR; PG8_SCHED;
            PG8_LDB(B0, 1, 0); PG8_LDB(B1, 1, 1); PG8_SCHED; PG8_LDA(At, 1, 0); PG8_STAGE(PG8_SA(0, 1), a2 + hstep, voffA);
            PG8_WAIT_V(8); PG8_WAIT_L(0); PG8_BAR; PG8_MMA(0, 0, At, B0); PG8_MMA(0, 1, At, B1); PG8_BAR; PG8_SCHED;
            PG8_LDA(At, 1, 1); PG8_STAGE(PG8_SB(1, 0), b3, voffB); PG8_STAGE(PG8_SB(1, 1), b3 + hstep, voffB); PG8_STAGE(PG8_SA(1, 0), a3, voffA);
            PG8_WAIT_V(8); PG8_WAIT_L(0); PG8_BAR; PG8_MMA(1, 0, At, B0); PG8_MMA(1, 1, At, B1); PG8_BAR; PG8_SCHED;
            } else {
            PG8_LDB(B0, 0, 0); PG8_SCHED; PG8_LDA(At, 0, 0); PG8_STAGE(PG8_SA(1, 1), a1 + hstep, voffA);
            PG8_WAIT_L(8); PG8_BAR; PG8_WAIT_L(0); PG8_MMA(0, 0, At, B0); PG8_BAR; PG8_SCHED;
            PG8_LDB(B1, 0, 1); PG8_STAGE(PG8_SB(0, 0), b2, voffB);
            PG8_BAR; PG8_WAIT_L(0); PG8_MMA(0, 1, At, B1); PG8_BAR;
            PG8_LDA(At, 0, 1); PG8_STAGE(PG8_SA(0, 0), a2, voffA);
            PG8_BAR; PG8_WAIT_L(0); PG8_MMA(1, 0, At, B0); PG8_BAR; PG8_SCHED;
            PG8_STAGE(PG8_SB(0, 1), b2 + hstep, voffB);
            PG8_WAIT_V(6); PG8_BAR; PG8_MMA(1, 1, At, B1); PG8_BAR;
            PG8_LDB(B0, 1, 0); PG8_SCHED; PG8_LDA(At, 1, 0); PG8_STAGE(PG8_SA(0, 1), a2 + hstep, voffA);
            PG8_WAIT_L(8); PG8_BAR; PG8_WAIT_L(0); PG8_MMA(0, 0, At, B0); PG8_BAR; PG8_SCHED;
            PG8_LDB(B1, 1, 1); PG8_STAGE(PG8_SB(1, 0), b3, voffB);
            PG8_BAR; PG8_WAIT_L(0); PG8_MMA(0, 1, At, B1); PG8_BAR;
            PG8_LDA(At, 1, 1); PG8_STAGE(PG8_SA(1, 0), a3, voffA);
            PG8_BAR; PG8_WAIT_L(0); PG8_MMA(1, 0, At, B0); PG8_BAR; PG8_SCHED;
            PG8_STAGE(PG8_SB(1, 1), b3 + hstep, voffB);
            PG8_WAIT_V(6); PG8_BAR; PG8_MMA(1, 1, At, B1); PG8_BAR;
            }
        }
        if constexpr (ALIGN_EPI) { if (wr == 0) PG8_BAR; }
        if constexpr (!Epi::AFTER_DRAIN) { E(acc, cur, wr, wc, fr, fq); S.done(cur); }
        if (!has_next) break;
#pragma unroll
        for (int a = 0; a < 2; ++a)
#pragma unroll
            for (int b = 0; b < 2; ++b)
#pragma unroll
                for (int m = 0; m < 4; ++m)
#pragma unroll
                    for (int n = 0; n < 2; ++n) acc[a][b][m][n] = (f32x4){0.f, 0.f, 0.f, 0.f};
        cur = nxt; cA = nA; cB = nB; ++ui;
        if constexpr (ALIGN_EPI) { if (wr == 1) PG8_BAR; }
    }
    PG8_WAIT_V(0);
    if constexpr (!ALIGN_EPI) { if (wr == 0) PG8_BAR; }
    PG8_BAR;
    if constexpr (Epi::AFTER_DRAIN) { E.fused(acc, cur, wr, wc, fr, fq, lds, wid, lane); S.done(cur); }
#undef PG8_SA
#undef PG8_SB
#undef PG8_STAGE
#undef PG8_LDA
#undef PG8_LDB
#undef PG8_MMA
#undef PG8_WAIT_V
#undef PG8_WAIT_L
#undef PG8_BAR
#undef PG8_SCHED
}
}

#define LAS __attribute__((address_space(3)))
typedef unsigned short bf16;
typedef short bf16x8 __attribute__((ext_vector_type(8)));
typedef float f32x4 __attribute__((ext_vector_type(4)));
typedef float f32x16 __attribute__((ext_vector_type(16)));
typedef unsigned u32x4 __attribute__((ext_vector_type(4)));
typedef unsigned u32x2 __attribute__((ext_vector_type(2)));

constexpr int NTHREADS = 512, NWAVES = 8;
constexpr int LDS_BYTES = 147456;
constexpr int MTOK = 16384, NPROMPT = 8192, KVROWS = 18432;
constexpr float RMS_EPS = 1e-6f;
constexpr size_t MiB = 1u << 20;
constexpr size_t WS_BAR = 768 * 1024, WS_BAR_BYTES = 16384;
constexpr int LDSCTL_OFF = 131072;
constexpr size_t WS_MOD = 0, WS_ROPE8 = 512 * 1024, WS_ROPE16 = WS_ROPE8 + 4096;
constexpr size_t WS_W_INAB = 1 * MiB, WS_W_UQ = 5 * MiB, WS_W_UKV = 5 * MiB + 512 * 1024, WS_W_OUTAB = 6 * MiB, WS_W_FFI = 8 * MiB, WS_W_FFO = 30 * MiB,
                 WS_W_INC = 41 * MiB, WS_W_OUTC = 48 * MiB;
constexpr size_t WS_X = 50 * MiB;
constexpr size_t WS_CQN = 50 * MiB, WS_CKVA = 58 * MiB, WS_KR = 67 * MiB, WS_DQ = 69 * MiB, WS_DK = 85 * MiB, WS_DV = 103 * MiB;
constexpr size_t WS_H = 114 * MiB, WS_Y = 146 * MiB, WS_QA = 121 * MiB, WS_KVA = 146 * MiB, WS_MERGED = 182 * MiB, WS_HID = 146 * MiB;
constexpr size_t WS_NP = 250 * MiB, WS_MP = 251 * MiB, WS_HS = 114 * MiB, WS_END = 256 * MiB;
constexpr size_t OUT_Y = 0, OUT_CKV = 16777216, OUT_KR = 17825792, OUT_DK = 18087936, OUT_DV = 22282240, OUT_C = 26476544, OUT_N = 30670848, OUT_M = 30703616;

struct Args { const float* in[30]; float* out; unsigned char* ws; int ph_lo, ph_hi; };

__device__ __forceinline__ unsigned f2bf(float f) { unsigned u = __float_as_uint(f); return (u + 0x7fffu + ((u >> 16) & 1u)) >> 16; }
__device__ __forceinline__ unsigned pk2(float lo, float hi) { return pg8::cvt_pk_bf16(lo, hi); }
__device__ __forceinline__ float bflo(unsigned w) { return __uint_as_float(w << 16); }
__device__ __forceinline__ float bfhi(unsigned w) { return __uint_as_float(w & 0xffff0000u); }
__device__ __forceinline__ float bf2f(bf16 b) { return __uint_as_float(((unsigned)b) << 16); }
__device__ __forceinline__ float wave_sum(float v) {
#pragma unroll
    for (int o = 1; o < 64; o <<= 1) v += __shfl_xor(v, o);
    return v;
}
__device__ __forceinline__ float wave_max(float v) {
#pragma unroll
    for (int o = 1; o < 64; o <<= 1) v = fmaxf(v, __shfl_xor(v, o));
    return v;
}
__device__ __forceinline__ float scan_sum(float v, int lane) {
#pragma unroll
    for (int o = 1; o < 64; o <<= 1) { float t = __shfl_up(v, o); if (lane >= o) v += t; }
    return v;
}
__device__ __forceinline__ float scan_max(float v, int lane) {
#pragma unroll
    for (int o = 1; o < 64; o <<= 1) { float t = __shfl_up(v, o); if (lane >= o) v = fmaxf(v, t); }
    return v;
}
__device__ __forceinline__ float log_sigmoid(float x) { return fminf(x, 0.f) - log1pf(expf(-fabsf(x))); }
__device__ __forceinline__ f32x16 mfma32(bf16x8 a, bf16x8 b, f32x16 c) { return __builtin_amdgcn_mfma_f32_32x32x16_bf16(a, b, c, 0, 0, 0); }
__device__ __forceinline__ bf16x8 pack8(float a0, float a1, float a2, float a3, float a4, float a5, float a6, float a7) {
    u32x4 w; w.x = pk2(a0, a1); w.y = pk2(a2, a3); w.z = pk2(a4, a5); w.w = pk2(a6, a7); return __builtin_bit_cast(bf16x8, w);
}

struct EpiGate {
    static constexpr bool PERM = true, AFTER_DRAIN = false;
    const float* baseP; const float* baseS; float* out; const float* mod;
    __device__ __forceinline__ void operator()(const pg8::f32x4 (&acc)[2][2][4][2], const pg8::Unit& u, int wr, int wc, int fr, int fq) const {
        const int rowb = u.pm * 256; const int n = rowb < NPROMPT ? 0 : 1 + ((rowb - NPROMPT) >> 10);
        const int row0 = rowb + wr * 64 + fr, col0 = u.pn * 256 + wc * 32 + 8 * fq;
        const float* gp = mod + n * 6144 + col0;
        f32x4 gv[2][2];
#pragma unroll
        for (int bj = 0; bj < 2; ++bj) { gv[bj][0] = *(const f32x4*)(gp + bj * 128); gv[bj][1] = *(const f32x4*)(gp + bj * 128 + 4); }
        const float* bb = rowb < NPROMPT ? baseP + (size_t)row0 * 1024 : baseS + (size_t)(row0 - NPROMPT) * 1024;
#pragma unroll
        for (int ai = 0; ai < 2; ++ai)
#pragma unroll
            for (int m = 0; m < 4; ++m) {
                const size_t ro = (size_t)(ai * 128 + m * 16) * 1024 + col0;
                float* op = out + (size_t)row0 * 1024 + ro;
#pragma unroll
                for (int bj = 0; bj < 2; ++bj) {
                    const f32x4 x0 = *(const f32x4*)(bb + ro + bj * 128), x1 = *(const f32x4*)(bb + ro + bj * 128 + 4);
                    *(f32x4*)(op + bj * 128) = x0 + gv[bj][0] * acc[ai][bj][m][0];
                    *(f32x4*)(op + bj * 128 + 4) = x1 + gv[bj][1] * acc[ai][bj][m][1];
                }
            }
    }
};
struct EpiSwiGLU {
    static constexpr bool PERM = true, AFTER_DRAIN = false;
    bf16* O;
    __device__ __forceinline__ void operator()(const pg8::f32x4 (&acc)[2][2][4][2], const pg8::Unit& u, int wr, int wc, int fr, int fq) const {
        const int row0 = u.pm * 256 + wr * 64 + fr, col0 = u.pn * 128 + wc * 32 + 8 * fq;
#pragma unroll
        for (int ai = 0; ai < 2; ++ai)
#pragma unroll
            for (int m = 0; m < 4; ++m) {
                float hv[8];
#pragma unroll
                for (int n = 0; n < 2; ++n)
#pragma unroll
                    for (int i = 0; i < 4; ++i) { const float av = acc[ai][0][m][n][i], bv = acc[ai][1][m][n][i]; hv[n * 4 + i] = av * bv * __builtin_amdgcn_rcpf(1.f + __expf(-av)); }
                u32x4 w; w.x = pk2(hv[0], hv[1]); w.y = pk2(hv[2], hv[3]); w.z = pk2(hv[4], hv[5]); w.w = pk2(hv[6], hv[7]);
                *(u32x4*)(O + (size_t)(row0 + ai * 128 + m * 16) * 2816 + col0) = w;
            }
    }
};

__device__ __forceinline__ void tr_item(const float* W, int N, bf16* WT, int ldk, int k0, int n0, int drow0, LAS float* scr, int lane) {
#pragma unroll 8
    for (int i = 0; i < 32; ++i) { const int kk = 2 * i + (lane >> 5); scr[kk * 33 + (lane & 31)] = W[(size_t)(k0 + kk) * N + n0 + (lane & 31)]; }
    __builtin_amdgcn_s_waitcnt(0); asm volatile("" ::: "memory");
    const int c = lane & 7;
#pragma unroll
    for (int j = 0; j < 4; ++j) { const int n = (lane >> 3) + 8 * j; const LAS float* s = scr + (8 * c) * 33 + n;
        u32x4 o; o.x = pk2(s[0 * 33], s[1 * 33]); o.y = pk2(s[2 * 33], s[3 * 33]); o.z = pk2(s[4 * 33], s[5 * 33]); o.w = pk2(s[6 * 33], s[7 * 33]);
        *(u32x4*)(WT + (size_t)(drow0 + n) * ldk + k0 + 8 * c) = o; }
    __builtin_amdgcn_s_waitcnt(0); asm volatile("" ::: "memory");
}

__device__ __forceinline__ void phase_prep(const Args& a, LAS unsigned char* lds) {
    const int tid = ltid(), lane = tid & 63, wave = tid >> 6, G = gridDim.x;
    unsigned char* ws = a.ws;
    float* MOD = (float*)(ws + WS_MOD);
    if (lbid() < 192) {
        LAS float* sS = (LAS float*)lds; LAS float* sRed = sS + 1024 * 12;
        for (int idx = tid; idx < 9 * 1024; idx += NTHREADS) { const int n = idx >> 10, k = idx & 1023; const float c = n == 0 ? a.in[10][k] : a.in[9][(n - 1) * 1024 + k]; sS[k * 12 + n] = c / (1.f + expf(-c)); }
        __syncthreads();
        for (int it = lbid(); it < 192; it += G) {
            const int l = it / 96, j0 = (it % 96) * 64, kg = tid >> 6, jl = tid & 63;
            const float* W = a.in[11] + ((size_t)l * 1024 + kg * 128) * 6144 + j0 + jl;
            float acc[9];
#pragma unroll
            for (int n = 0; n < 9; ++n) acc[n] = 0.f;
#pragma unroll 8
            for (int k = 0; k < 128; ++k) {
                const float w = W[(size_t)k * 6144]; const LAS float* s = sS + (kg * 128 + k) * 12;
                const f32x4 s0 = *(const LAS f32x4*)s, s1 = *(const LAS f32x4*)(s + 4); const float s8 = s[8];
                acc[0] += w * s0.x; acc[1] += w * s0.y; acc[2] += w * s0.z; acc[3] += w * s0.w; acc[4] += w * s1.x; acc[5] += w * s1.y; acc[6] += w * s1.z; acc[7] += w * s1.w; acc[8] += w * s8;
            }
#pragma unroll
            for (int n = 0; n < 9; ++n) sRed[(kg * 64 + jl) * 9 + n] = acc[n];
            __syncthreads();
            for (int idx = tid; idx < 576; idx += NTHREADS) { const int n = idx >> 6, j2 = idx & 63; float s = a.in[12][l * 6144 + j0 + j2];
#pragma unroll
                for (int g = 0; g < 8; ++g) s += sRed[(g * 64 + j2) * 9 + n];
                MOD[(l * 9 + n) * 6144 + j0 + j2] = s; }
            __syncthreads();
        }
    }
    __syncthreads();
    if (lbid() == 0) {
        float* R8 = (float*)(ws + WS_ROPE8); float* R16 = (float*)(ws + WS_ROPE16);
        { const int pos = tid >> 3, i = tid & 7; const float fr = (float)pow(10000.0, -(double)i / 8.0); const float ang = (float)pos * fr; R8[tid * 2] = (float)cos((double)ang); R8[tid * 2 + 1] = (float)sin((double)ang); }
        for (int e = tid; e < 1024; e += NTHREADS) { const int pos = e >> 4, i = e & 15; const float fr = (float)pow(10000.0, -(double)i / 16.0); const float ang = (float)pos * fr; R16[e * 2] = (float)cos((double)ang); R16[e * 2 + 1] = (float)sin((double)ang); }
    }
    {
        const int gt = lbid() * NTHREADS + tid, NGT = G * NTHREADS; const u32x4 z = {0u, 0u, 0u, 0u};
        bf16* wukv = (bf16*)(ws + WS_W_UKV);
        for (int i = gt; i < 1024 * 16; i += NGT) *(u32x4*)(wukv + (size_t)(i >> 4) * 256 + 128 + (i & 15) * 8) = z;
        u32x4* p1 = (u32x4*)((bf16*)(ws + WS_W_INAB) + (size_t)1952 * 1024);
        for (int i = gt; i < 12288; i += NGT) p1[i] = z;
        u32x4* p2 = (u32x4*)((bf16*)(ws + WS_W_INC) + (size_t)3104 * 1024);
        for (int i = gt; i < 28672; i += NGT) p2[i] = z;
    }
    {
        LAS float* scr = (LAS float*)lds + wave * (64 * 33);
        const int gw = lbid() * NWAVES + wave, NGW = G * NWAVES;
        constexpr int NITEMS = 976 + 96 + 64 + 512 + 5632 + 2816 + 1552 + 512;
        for (int it = gw; it < NITEMS; it += NGW) {
            int r = it; const float* W; int N, ldk, mode = 0; bf16* WT;
            if (r < 976) { W = a.in[17]; N = 1952; WT = (bf16*)(ws + WS_W_INAB); ldk = 1024; }
            else if ((r -= 976) < 96) { W = a.in[20]; N = 768; WT = (bf16*)(ws + WS_W_UQ); ldk = 256; }
            else if ((r -= 96) < 64) { W = a.in[21]; N = 1024; WT = (bf16*)(ws + WS_W_UKV); ldk = 256; }
            else if ((r -= 64) < 512) { W = a.in[24]; N = 1024; WT = (bf16*)(ws + WS_W_OUTAB); ldk = 1024; }
            else if ((r -= 512) < 5632) { const int l = r / 2816; r -= l * 2816; W = a.in[15] + (size_t)l * 1024 * 5632; N = 5632; WT = (bf16*)(ws + WS_W_FFI) + (size_t)l * 5632 * 1024; ldk = 1024; mode = 1; }
            else if ((r -= 5632) < 2816) { const int l = r / 1408; r -= l * 1408; W = a.in[16] + (size_t)l * 2816 * 1024; N = 1024; WT = (bf16*)(ws + WS_W_FFO) + (size_t)l * 1024 * 2816; ldk = 2816; }
            else if ((r -= 2816) < 1552) { W = a.in[25]; N = 3104; WT = (bf16*)(ws + WS_W_INC); ldk = 1024; }
            else { r -= 1552; W = a.in[28]; N = 1024; WT = (bf16*)(ws + WS_W_OUTC); ldk = 1024; }
            const int nblk = N / 32, kb = r / nblk, nb = r % nblk, k0 = 64 * kb, n0 = 32 * nb;
            const int drow0 = mode ? ((n0 % 2816) / 128) * 256 + (n0 / 2816) * 128 + (n0 % 128) : n0;
            tr_item(W, N, WT, ldk, k0, n0, drow0, scr, lane);
        }
    }
}

__device__ __forceinline__ void phase_rowwise(const Args& a, int ph) {
    const int tid = ltid(), lane = tid & 63, wave = tid >> 6, G = gridDim.x;
    unsigned char* ws = a.ws;
    const int L = ph >= 10 ? 1 : 0;
    const bool fin = ph == 18, ffn = (ph == 7 || ph == 15);
    const float* g = fin ? a.in[29] : (ffn ? a.in[14] : a.in[13]) + L * 1024;
    const float* MOD = (const float*)(ws + WS_MOD) + (size_t)L * 9 * 6144 + (ffn ? 3072 : 0);
    const float* X = (const float*)(ws + WS_X); bf16* H = (bf16*)(ws + WS_H);
    f32x4 gv[4];
#pragma unroll
    for (int j = 0; j < 4; ++j) gv[j] = *(const f32x4*)(g + 4 * lane + 256 * j);
    for (int m = lbid() * NWAVES + wave; m < MTOK; m += G * NWAVES) {
        const float* xr = ph == 1 ? (m < NPROMPT ? a.in[0] + (size_t)m * 1024 : a.in[1] + (size_t)(m - NPROMPT) * 1024) : X + (size_t)m * 1024;
        f32x4 v[4]; float ss = 0.f;
#pragma unroll
        for (int j = 0; j < 4; ++j) { v[j] = *(const f32x4*)(xr + 4 * lane + 256 * j); ss += (v[j].x * v[j].x + v[j].y * v[j].y) + (v[j].z * v[j].z + v[j].w * v[j].w); }
        const float rstd = rsqrtf(wave_sum(ss) * (1.f / 1024.f) + RMS_EPS);
        if (fin) {
            float* o = a.out + OUT_Y + (size_t)m * 1024;
#pragma unroll
            for (int j = 0; j < 4; ++j) *(f32x4*)(o + 4 * lane + 256 * j) = v[j] * rstd * gv[j];
        } else {
            const int n = m < NPROMPT ? 0 : 1 + ((m - NPROMPT) >> 10);
            const float* sh = MOD + n * 6144; const float* sc = sh + 1024;
#pragma unroll
            for (int j = 0; j < 4; ++j) {
                const f32x4 s4 = *(const f32x4*)(sc + 4 * lane + 256 * j), h4 = *(const f32x4*)(sh + 4 * lane + 256 * j);
                const f32x4 y = v[j] * rstd * gv[j] * (1.f + s4) + h4;
                u32x2 w; w.x = pk2(y.x, y.y); w.y = pk2(y.z, y.w);
                *(u32x2*)(H + (size_t)m * 1024 + 4 * lane + 256 * j) = w;
            }
        }
    }
}
#define XB_TMO      128
#define XB_XCNT(j)  (256  + 64 * (j))
#define XB_XSUB(j)  (1280 + 64 * (j))
#define XB_XGEN(j)  (2304 + 64 * (j))
#define XB_TOP      3328
#define XB_TOPGEN   3392
#define XCD_BAR_WORDS 3456
#define XB_SPIN_CAP (1u << 18)

__device__ __forceinline__ unsigned xb_ld(unsigned* p)              { return __hip_atomic_load(p, __ATOMIC_RELAXED, __HIP_MEMORY_SCOPE_AGENT); }
__device__ __forceinline__ unsigned xb_add(unsigned* p, unsigned v) { return __hip_atomic_fetch_add(p, v, __ATOMIC_RELAXED, __HIP_MEMORY_SCOPE_AGENT); }
__device__ __forceinline__ unsigned xb_xcc_id() { return (unsigned)__builtin_amdgcn_s_getreg((3 << 11) | 20) & 0xFu; }
#define XB_SPIN(cond, bar) do { unsigned _sp = 0; while (cond) { __builtin_amdgcn_s_sleep(1); \
    if ((++_sp & 255u) == 0u) { if (xb_ld(&(bar)[XB_TMO])) break; if (_sp > XB_SPIN_CAP) { atomicAdd(&(bar)[XB_TMO], 1u); break; } } } } while (0)

struct XcdBarrier {
    unsigned* bar; unsigned x;
    volatile LAS unsigned* st;
};

__device__ __forceinline__ XcdBarrier xcd_barrier_post(unsigned* bar, volatile LAS unsigned* st) {
    XcdBarrier b; b.bar = bar; b.x = xb_xcc_id(); b.st = st;
    if (threadIdx.x == 0) (void)xb_add(&bar[XB_XCNT(b.x)], 1u);
    return b;
}
__device__ __forceinline__ void xcd_barrier_complete(unsigned* bar, unsigned x, unsigned& nloc, unsigned& nx) {
    const unsigned G = gridDim.x * gridDim.y * gridDim.z;
    unsigned sum, cnt, mine, sp = 0u;
    for (;;) {
        sum = 0u; cnt = 0u; mine = 0u;
#pragma unroll
        for (unsigned j = 0; j < 16; ++j) { const unsigned c = xb_ld(&bar[XB_XCNT(j)]); sum += c; cnt += (c > 0u) ? 1u : 0u; mine = (j == x) ? c : mine; }
        if (sum == G) break;
        __builtin_amdgcn_s_sleep(1);
        if ((++sp & 255u) == 0u) { if (xb_ld(&bar[XB_TMO])) break; if (sp > XB_SPIN_CAP) { atomicAdd(&bar[XB_TMO], 1u); break; } }
    }
    nloc = mine > 0u ? mine : 1u; nx = cnt > 0u ? cnt : 1u;
}

__device__ __forceinline__ void xcd_barrier(const XcdBarrier& b) {
    asm volatile("s_waitcnt vmcnt(0)" ::: "memory");
    __syncthreads();
    if (threadIdx.x == 0) {
        unsigned* bar = b.bar;
        __builtin_amdgcn_s_waitcnt(0);
        unsigned nloc = b.st[0], nx = b.st[1];
        if (nloc == 0u) { xcd_barrier_complete(bar, b.x, nloc, nx); b.st[0] = nloc; b.st[1] = nx; }
        const unsigned old = xb_add(&bar[XB_XSUB(b.x)], 1u);
        const unsigned gen = old / nloc;
        if (old + 1u == (gen + 1u) * nloc) {
            __builtin_amdgcn_fence(__ATOMIC_RELEASE, "agent");
            asm volatile("s_waitcnt vmcnt(0)" ::: "memory");
            const unsigned og = xb_add(&bar[XB_TOP], 1u);
            const unsigned tg = og / nx;
            if (og + 1u == (tg + 1u) * nx) xb_add(&bar[XB_TOPGEN], 1u);
            else XB_SPIN(xb_ld(&bar[XB_TOPGEN]) == tg, bar);
            __builtin_amdgcn_fence(__ATOMIC_ACQUIRE, "agent");
            xb_add(&bar[XB_XGEN(b.x)], 1u);
            asm volatile("s_waitcnt vmcnt(0)" ::: "memory");
        } else {
            XB_SPIN(xb_ld(&bar[XB_XGEN(b.x)]) == gen, bar);
            __builtin_amdgcn_fence(__ATOMIC_ACQUIRE, "agent");
            asm volatile("s_waitcnt vmcnt(0)" ::: "memory");
        }
    }
    __syncthreads();
}

__device__ __forceinline__ void rope8(u32x4& w, const u32x4 p, const float* cs, bool second) {
    float x[8], y[8];
    x[0] = bflo(w.x); x[1] = bfhi(w.x); x[2] = bflo(w.y); x[3] = bfhi(w.y); x[4] = bflo(w.z); x[5] = bfhi(w.z); x[6] = bflo(w.w); x[7] = bfhi(w.w);
    y[0] = bflo(p.x); y[1] = bfhi(p.x); y[2] = bflo(p.y); y[3] = bfhi(p.y); y[4] = bflo(p.z); y[5] = bfhi(p.z); y[6] = bflo(p.w); y[7] = bfhi(p.w);
    float o[8];
#pragma unroll
    for (int j = 0; j < 8; ++j) { const float c = cs[2 * j], s = cs[2 * j + 1]; o[j] = second ? y[j] * s + x[j] * c : x[j] * c - y[j] * s; }
    w.x = pk2(o[0], o[1]); w.y = pk2(o[2], o[3]); w.z = pk2(o[4], o[5]); w.w = pk2(o[6], o[7]);
}
__device__ __forceinline__ u32x4 shfl_xor4(u32x4 v, int m) { u32x4 r; r.x = __shfl_xor(v.x, m); r.y = __shfl_xor(v.y, m); r.z = __shfl_xor(v.z, m); r.w = __shfl_xor(v.w, m); return r; }
__device__ __forceinline__ void st_f32x8(float* p, u32x4 w) {
    *(f32x4*)p = (f32x4){bflo(w.x), bfhi(w.x), bflo(w.y), bfhi(w.y)}; *(f32x4*)(p + 4) = (f32x4){bflo(w.z), bfhi(w.z), bflo(w.w), bfhi(w.w)};
}

__device__ __forceinline__ void phase_split(const Args& a) {
    const int tid = ltid(), lane = tid & 63, wave = tid >> 6, G = gridDim.x;
    unsigned char* ws = a.ws;
    const bf16* Y = (const bf16*)(ws + WS_Y);
    bf16* CQN = (bf16*)(ws + WS_CQN); bf16* CKVA = (bf16*)(ws + WS_CKVA); bf16* KR = (bf16*)(ws + WS_KR);
    bf16* DQ = (bf16*)(ws + WS_DQ); bf16* DK = (bf16*)(ws + WS_DK); bf16* DV = (bf16*)(ws + WS_DV);
    const float* R8 = (const float*)(ws + WS_ROPE8); const float* R16 = (const float*)(ws + WS_ROPE16);
    const float* gql = a.in[18]; const float* gkv = a.in[19];
    for (int kvrow = lbid() * NWAVES + wave; kvrow < KVROWS; kvrow += G * NWAVES) {
        int m, b, t; bool sample = false, cache = false;
        if (kvrow < NPROMPT) { m = kvrow; b = m >> 8; t = m & 255; }
        else { const int r = kvrow - NPROMPT; b = r / 1280; const int k = r - b * 1280; if (k < 1024) { sample = true; t = k; m = NPROMPT + b * 1024 + k; } else { cache = true; t = k - 1024; m = 0; } }
        *(unsigned*)(CKVA + (size_t)kvrow * 256 + 128 + 2 * lane) = 0u;
        if (cache) {
            const float* s = a.in[2] + (size_t)(b * 256 + t) * 128 + 2 * lane;
            *(unsigned*)(CKVA + (size_t)kvrow * 256 + 2 * lane) = pk2(s[0], s[1]);
            if (lane < 32) KR[(size_t)kvrow * 32 + lane] = (bf16)f2bf(a.in[3][(size_t)(b * 256 + t) * 32 + lane]);
            const int hb = lane >> 4; const size_t so = ((size_t)(b * 4 + hb) * 256 + t) * 128 + (lane & 15) * 8;
            { const f32x4 x0 = *(const f32x4*)(a.in[4] + so), x1 = *(const f32x4*)(a.in[4] + so + 4);
              u32x4 w; w.x = pk2(x0.x, x0.y); w.y = pk2(x0.z, x0.w); w.z = pk2(x1.x, x1.y); w.w = pk2(x1.z, x1.w); *(u32x4*)(DK + (size_t)kvrow * 512 + 8 * lane) = w; }
            { const f32x4 x0 = *(const f32x4*)(a.in[5] + so), x1 = *(const f32x4*)(a.in[5] + so + 4);
              u32x4 w; w.x = pk2(x0.x, x0.y); w.y = pk2(x0.z, x0.w); w.z = pk2(x1.x, x1.y); w.w = pk2(x1.z, x1.w); *(u32x4*)(DV + (size_t)kvrow * 512 + 8 * lane) = w; }
            continue;
        }
        const bf16* yr = Y + (size_t)m * 2048;
        const int grow = t >> 6, gcol = t & 63;
        { const u32x2 w = *(const u32x2*)(yr + 4 * lane); const float x0 = bflo(w.x), x1 = bfhi(w.x), x2 = bflo(w.y), x3 = bfhi(w.y);
          const float rstd = rsqrtf(wave_sum(x0 * x0 + x1 * x1 + x2 * x2 + x3 * x3) * (1.f / 256.f) + RMS_EPS);
          const f32x4 gq = *(const f32x4*)(gql + 4 * lane);
          u32x2 o; o.x = pk2(x0 * rstd * gq.x, x1 * rstd * gq.y); o.y = pk2(x2 * rstd * gq.z, x3 * rstd * gq.w);
          *(u32x2*)(CQN + (size_t)m * 256 + 4 * lane) = o; }
        { const unsigned w = *(const unsigned*)(yr + 256 + 2 * lane); const float x0 = bflo(w), x1 = bfhi(w);
          const float rstd = rsqrtf(wave_sum(x0 * x0 + x1 * x1) * (1.f / 128.f) + RMS_EPS);
          const float y0 = x0 * rstd * gkv[2 * lane], y1 = x1 * rstd * gkv[2 * lane + 1];
          if (!sample) { float* o = a.out + OUT_CKV + (size_t)m * 128 + 2 * lane; o[0] = y0; o[1] = y1; }
          *(unsigned*)(CKVA + (size_t)kvrow * 256 + 2 * lane) = pk2(y0, y1); }
        { float x = lane < 32 ? bf2f(yr[384 + lane]) : 0.f; const float p = __shfl_xor(x, 8);
          if (sample) { const int grp = (lane >> 3) & 3, i = lane & 7; const int pos = grp < 2 ? grow : gcol; const float c = R8[(pos * 8 + i) * 2], s = R8[(pos * 8 + i) * 2 + 1];
              x = (grp & 1) ? p * s + x * c : x * c - p * s; }
          if (lane < 32) { if (!sample) a.out[OUT_KR + (size_t)m * 32 + lane] = x; KR[(size_t)kvrow * 32 + lane] = (bf16)f2bf(x); } }
        const int s8 = lane & 7; const int pos16 = s8 < 4 ? grow : gcol; const int fi0 = (s8 & 1) * 8; const bool second = (s8 & 2) != 0;
        const float* cs = R16 + (pos16 * 16 + fi0) * 2;
        const int hb = lane >> 4; const size_t oo = ((size_t)(b * 4 + hb) * 256 + t) * 128 + (lane & 15) * 8;
        { u32x4 w = *(const u32x4*)(yr + 416 + 8 * lane); const u32x4 p = shfl_xor4(w, 2); if (sample) rope8(w, p, cs, second); *(u32x4*)(DQ + (size_t)m * 512 + 8 * lane) = w; }
        { u32x4 w = *(const u32x4*)(yr + 928 + 8 * lane); const u32x4 p = shfl_xor4(w, 2); if (sample) rope8(w, p, cs, second); else st_f32x8(a.out + OUT_DK + oo, w);
          *(u32x4*)(DK + (size_t)kvrow * 512 + 8 * lane) = w; }
        { const u32x4 w = *(const u32x4*)(yr + 1440 + 8 * lane); if (!sample) st_f32x8(a.out + OUT_DV + oo, w); *(u32x4*)(DV + (size_t)kvrow * 512 + 8 * lane) = w; }
    }
}

template <int D, int DV>
__device__ __forceinline__ void attn_pass(LAS unsigned char* lds, const bf16x8 (&qf)[D / 16], const bf16* kA, int ldA, const bf16* kB, int ldB,
                                          const bf16* vS, int ldV, int nkeys, float csc, f32x16 (&o)[DV / 32]) {
    constexpr int KS = (D + 8) * 2, VS = 144, KP = D / 8, VP = DV / 8;
    LAS unsigned char* Kl = lds; LAS unsigned char* VT = lds + 64 * KS;
    const int tid = ltid(), lane = tid & 63, r32 = lane & 31, hi = lane >> 5;
    const int prow = (r32 & ~12) | (((r32 >> 2) & 1) << 3) | (((r32 >> 3) & 1) << 2);
    const int kkey0 = tid / KP, kdc0 = tid % KP, kkey1 = (tid + 512) / KP, kdc1 = (tid + 512) % KP;
    const bool k2 = (64 * KP > 512) && (tid + 512 < 64 * KP);
    const int vkey0 = tid / VP, vc0 = tid % VP;
    const bf16* ksrc0 = kdc0 < 8 ? kA + (size_t)kkey0 * ldA + kdc0 * 8 : kB + (size_t)kkey0 * ldB + (kdc0 - 8) * 8;
    const size_t kst0 = kdc0 < 8 ? (size_t)64 * ldA : (size_t)64 * ldB;
    const bf16* ksrc1 = kdc1 < 8 ? kA + (size_t)kkey1 * ldA + kdc1 * 8 : kB + (size_t)kkey1 * ldB + (kdc1 - 8) * 8;
    const size_t kst1 = kdc1 < 8 ? (size_t)64 * ldA : (size_t)64 * ldB;
    const bf16* vsrc0 = vS + (size_t)vkey0 * ldV + vc0 * 8;
    const bf16* vsrc1 = vsrc0 + (size_t)(512 / VP) * ldV;
    const size_t vst = (size_t)64 * ldV;
    u32x4 kr0, kr1 = {0u, 0u, 0u, 0u}, vr0, vr1 = {0u, 0u, 0u, 0u};
#define ATT_LOAD(t) do { kr0 = *(const u32x4*)(ksrc0 + (t) * kst0); if (k2) kr1 = *(const u32x4*)(ksrc1 + (t) * kst1); \
        vr0 = *(const u32x4*)(vsrc0 + (t) * vst); if (VP == 16) vr1 = *(const u32x4*)(vsrc1 + (t) * vst); } while (0)
#define ATT_VTW(reg, key, c) do { LAS bf16* vt_ = (LAS bf16*)VT + (size_t)((c) * 8) * 72 + (key); \
        vt_[0] = (bf16)(reg.x & 0xffffu); vt_[72] = (bf16)(reg.x >> 16); vt_[144] = (bf16)(reg.y & 0xffffu); vt_[216] = (bf16)(reg.y >> 16); \
        vt_[288] = (bf16)(reg.z & 0xffffu); vt_[360] = (bf16)(reg.z >> 16); vt_[432] = (bf16)(reg.w & 0xffffu); vt_[504] = (bf16)(reg.w >> 16); } while (0)
    float mrun = -1e30f, lsum = 0.f;
#pragma unroll
    for (int i = 0; i < DV / 32; ++i)
#pragma unroll
        for (int r = 0; r < 16; ++r) o[i][r] = 0.f;
    const int NT = nkeys >> 6;
    ATT_LOAD(0);
    for (int t = 0; t < NT; ++t) {
        *(LAS u32x4*)(Kl + kkey0 * KS + kdc0 * 16) = kr0;
        if (k2) *(LAS u32x4*)(Kl + kkey1 * KS + kdc1 * 16) = kr1;
        ATT_VTW(vr0, vkey0, vc0);
        if (VP == 16) ATT_VTW(vr1, vkey0 + 32, vc0);
        __syncthreads();
        if (t + 1 < NT) ATT_LOAD(t + 1);
        f32x16 s0, s1;
#pragma unroll
        for (int r = 0; r < 16; ++r) { s0[r] = 0.f; s1[r] = 0.f; }
#pragma unroll
        for (int dc = 0; dc < D / 16; ++dc) {
            const bf16x8 k0 = *(const LAS bf16x8*)(Kl + prow * KS + (dc * 16 + hi * 8) * 2);
            const bf16x8 k1 = *(const LAS bf16x8*)(Kl + (32 + prow) * KS + (dc * 16 + hi * 8) * 2);
            s0 = mfma32(k0, qf[dc], s0); s1 = mfma32(k1, qf[dc], s1);
        }
        float mx = -1e30f;
#pragma unroll
        for (int r = 0; r < 16; ++r) mx = fmaxf(mx, fmaxf(s0[r], s1[r]));
        mx *= csc; mx = fmaxf(mx, __shfl_xor(mx, 32));
        const float mn = fmaxf(mrun, mx); const float alpha = __builtin_amdgcn_exp2f(mrun - mn); mrun = mn;
        lsum *= alpha;
#pragma unroll
        for (int i = 0; i < DV / 32; ++i)
#pragma unroll
            for (int r = 0; r < 16; ++r) o[i][r] *= alpha;
#pragma unroll
        for (int r = 0; r < 16; ++r) { s0[r] = __builtin_amdgcn_exp2f(s0[r] * csc - mn); s1[r] = __builtin_amdgcn_exp2f(s1[r] * csc - mn); lsum += s0[r] + s1[r]; }
        bf16x8 pf[4];
        pf[0] = pack8(s0[0], s0[1], s0[2], s0[3], s0[4], s0[5], s0[6], s0[7]); pf[1] = pack8(s0[8], s0[9], s0[10], s0[11], s0[12], s0[13], s0[14], s0[15]);
        pf[2] = pack8(s1[0], s1[1], s1[2], s1[3], s1[4], s1[5], s1[6], s1[7]); pf[3] = pack8(s1[8], s1[9], s1[10], s1[11], s1[12], s1[13], s1[14], s1[15]);
#pragma unroll
        for (int dvt = 0; dvt < DV / 32; ++dvt)
#pragma unroll
            for (int kc = 0; kc < 4; ++kc) {
                const bf16x8 v = *(const LAS bf16x8*)(VT + (dvt * 32 + r32) * VS + (16 * kc + 8 * hi) * 2);
                o[dvt] = mfma32(v, pf[kc], o[dvt]);
            }
        __syncthreads();
    }
#undef ATT_LOAD
#undef ATT_VTW
    lsum += __shfl_xor(lsum, 32);
    const float inv = 1.f / lsum;
#pragma unroll
    for (int i = 0; i < DV / 32; ++i)
#pragma unroll
        for (int r = 0; r < 16; ++r) o[i][r] *= inv;
}

__device__ __forceinline__ void attn_mla_unit(const Args& a, LAS unsigned char* lds, bool isS, int b, int h, int qb) {
    unsigned char* ws = a.ws;
    const int tid = ltid(), lane = tid & 63, wave = tid >> 6, r32 = lane & 31, hi = lane >> 5;
    const bf16* QA = (const bf16*)(ws + WS_QA); const bf16* KVA = (const bf16*)(ws + WS_KVA); const bf16* KR = (const bf16*)(ws + WS_KR);
    bf16* MG = (bf16*)(ws + WS_MERGED);
    const int tq = qb * 256 + wave * 32 + r32;
    const int mq = isS ? NPROMPT + b * 1024 + tq : b * 256 + tq;
    const int kvrow0 = isS ? NPROMPT + b * 1280 : b * 256, nkeys = isS ? 1280 : 256;
    const bf16* qp = QA + (size_t)mq * 768 + h * 96;
    bf16x8 qf[6];
#pragma unroll
    for (int dc = 0; dc < 4; ++dc) qf[dc] = *(const bf16x8*)(qp + dc * 16 + hi * 8);
    if (isS) {
        const float* R8 = (const float*)(ws + WS_ROPE8);
#pragma unroll
        for (int dc = 4; dc < 6; ++dc) {
            u32x4 x1 = *(const u32x4*)(qp + dc * 16), x2 = *(const u32x4*)(qp + dc * 16 + 8);
            const int pos = dc == 4 ? (tq >> 6) : (tq & 63);
            if (hi) { u32x4 tmp = x2; rope8(tmp, x1, R8 + pos * 16, true); qf[dc] = __builtin_bit_cast(bf16x8, tmp); }
            else { u32x4 tmp = x1; rope8(tmp, x2, R8 + pos * 16, false); qf[dc] = __builtin_bit_cast(bf16x8, tmp); }
        }
    } else {
        qf[4] = *(const bf16x8*)(qp + 64 + hi * 8); qf[5] = *(const bf16x8*)(qp + 80 + hi * 8);
    }
    f32x16 o[2];
    const float csc = 0.10206207261596575f * 1.4426950408889634f;
    attn_pass<96, 64>(lds, qf, KVA + (size_t)kvrow0 * 1024 + h * 128, 1024, KR + (size_t)kvrow0 * 32, 32, KVA + (size_t)kvrow0 * 1024 + h * 128 + 64, 1024, nkeys, csc, o);
    bf16* op = MG + (size_t)mq * 1024 + h * 64 + 4 * hi;
#pragma unroll
    for (int dvt = 0; dvt < 2; ++dvt)
#pragma unroll
        for (int g = 0; g < 4; ++g) { u32x2 w; w.x = pk2(o[dvt][4 * g], o[dvt][4 * g + 1]); w.y = pk2(o[dvt][4 * g + 2], o[dvt][4 * g + 3]); *(u32x2*)(op + dvt * 32 + g * 8) = w; }
}

__device__ __forceinline__ void attn_diff_unit(const Args& a, LAS unsigned char* lds, bool isS, int b, int hb, int qb, float lam) {
    unsigned char* ws = a.ws;
    const int tid = ltid(), lane = tid & 63, wave = tid >> 6, r32 = lane & 31, hi = lane >> 5;
    const bf16* DQ = (const bf16*)(ws + WS_DQ); const bf16* DK = (const bf16*)(ws + WS_DK); const bf16* DV = (const bf16*)(ws + WS_DV);
    bf16* MG = (bf16*)(ws + WS_MERGED);
    const int tq = qb * 256 + wave * 32 + r32;
    const int mq = isS ? NPROMPT + b * 1024 + tq : b * 256 + tq;
    const int kvrow0 = isS ? NPROMPT + b * 1280 : b * 256, nkeys = isS ? 1280 : 256;
    const float csc = 0.125f * 1.4426950408889634f;
    unsigned o1p[4][8];
    f32x16 o[4];
#pragma unroll 1
    for (int sub = 0; sub < 2; ++sub) {
        const bf16* qp = DQ + (size_t)mq * 512 + hb * 128 + sub * 64;
        bf16x8 qf[4];
#pragma unroll
        for (int dc = 0; dc < 4; ++dc) qf[dc] = *(const bf16x8*)(qp + dc * 16 + hi * 8);
        attn_pass<64, 128>(lds, qf, DK + (size_t)kvrow0 * 512 + hb * 128 + sub * 64, 512, nullptr, 0, DV + (size_t)kvrow0 * 512 + hb * 128, 512, nkeys, csc, o);
        if (sub == 0) {
#pragma unroll
            for (int i = 0; i < 4; ++i)
#pragma unroll
                for (int r = 0; r < 8; ++r) o1p[i][r] = pk2(o[i][2 * r], o[i][2 * r + 1]);
        }
    }
    float ss = 0.f;
#pragma unroll
    for (int i = 0; i < 4; ++i)
#pragma unroll
        for (int r = 0; r < 8; ++r) { const float d0 = bflo(o1p[i][r]) - lam * o[i][2 * r], d1 = bfhi(o1p[i][r]) - lam * o[i][2 * r + 1]; o[i][2 * r] = d0; o[i][2 * r + 1] = d1; ss += d0 * d0 + d1 * d1; }
    ss += __shfl_xor(ss, 32);
    const float rstd = rsqrtf(ss * (1.f / 128.f) + RMS_EPS) * 0.8f;
    const float* gs = a.in[23];
    bf16* op = MG + (size_t)mq * 1024 + 512 + hb * 128 + 4 * hi;
#pragma unroll
    for (int dvt = 0; dvt < 4; ++dvt)
#pragma unroll
        for (int g = 0; g < 4; ++g) {
            const f32x4 gv = *(const f32x4*)(gs + dvt * 32 + g * 8 + 4 * hi);
            u32x2 w; w.x = pk2(o[dvt][4 * g] * rstd * gv.x, o[dvt][4 * g + 1] * rstd * gv.y); w.y = pk2(o[dvt][4 * g + 2] * rstd * gv.z, o[dvt][4 * g + 3] * rstd * gv.w);
            *(u32x2*)(op + dvt * 32 + g * 8) = w;
        }
}

__device__ __forceinline__ void phase_attn(const Args& a, LAS unsigned char* lds) {
    const int lane = ltid() & 63, G = gridDim.x;
    const float* lv = a.in[22];
    const float lam = expf(wave_sum(lv[lane] * lv[64 + lane])) - expf(wave_sum(lv[128 + lane] * lv[192 + lane])) + 0.2f;
    for (int Lx = lbid(); Lx < 1024; Lx += G) {
        const int s = Lx >> 8, i = Lx & 255;
        if (i < 128) {
            if (s == 0) attn_diff_unit(a, lds, true, i >> 4, (i >> 2) & 3, i & 3, lam);
            else if (s == 1) attn_mla_unit(a, lds, false, i >> 3, i & 7, 0);
        } else {
            const int j = i - 128;
            if (s < 2) { const int u = 2 * j + s; attn_mla_unit(a, lds, true, u >> 5, (u >> 2) & 7, u & 3); }
            else if (s == 2) attn_mla_unit(a, lds, false, i >> 3, i & 7, 0);
            else attn_diff_unit(a, lds, false, j >> 2, j & 3, 0, lam);
        }
    }
}

__device__ __forceinline__ void scan_unit(const Args& a, LAS unsigned char* lds, bool isS, int b, int h, int dir) {
    unsigned char* ws = a.ws;
    const int tid = ltid(), lane = tid & 63, wave = tid >> 6, r32 = lane & 31, hi = lane >> 5;
    const bf16* Y2 = (const bf16*)(ws + WS_Y);
    bf16* CP = (bf16*)(a.out + OUT_Y); float* NP = (float*)(ws + WS_NP); float* MP = (float*)(ws + WS_MP);
    const float* bg = a.in[26];
    const int T = isS ? 1024 : 256, nc = isS ? 16 : 4, tok0 = isS ? NPROMPT + b * 1024 : b * 256;
    const int cpbase = isS ? 2048 + ((b * 8 + h) * 2 + dir) * 16 : ((b * 8 + h) * 2 + dir) * 4;
    LAS bf16* kT = (LAS bf16*)lds; LAS bf16* vT = kT + 64 * 72; LAS float* sW = (LAS float*)(vT + 128 * 72); LAS float* sSc = sW + 64;
    const int dt = wave & 1, et = wave >> 1;
    f32x16 C; float nst = 0.f, mst = 0.f;
#pragma unroll
    for (int r = 0; r < 16; ++r) C[r] = 0.f;
    if (isS) {
        const size_t sb = (size_t)((b * 2 + dir) * 8 + h);
        const float* C0 = a.in[6] + sb * 8192;
#pragma unroll
        for (int r = 0; r < 16; ++r) C[r] = C0[(size_t)(32 * dt + (r & 3) + 8 * (r >> 2) + 4 * hi) * 128 + 32 * et + r32];
        nst = a.in[7][sb * 64 + lane]; mst = a.in[8][sb];
    }
    const float bgi = bg[(2 * dir) * 8 + h], bgf = bg[(2 * dir + 1) * 8 + h];
    for (int c = 0; c < nc; ++c) {
        if (wave == 0) {
            const int tok = tok0 + (dir ? T - 1 - (64 * c + lane) : 64 * c + lane);
            const bf16* yr = Y2 + (size_t)tok * 3328 + 3072;
            const float gi = bf2f(yr[(2 * dir) * 8 + h]) + bgi, gf = bf2f(yr[(2 * dir + 1) * 8 + h]) + bgf;
            const float lf = log_sigmoid(gf);
            const float bc = scan_sum(lf, lane); const float g = __shfl(bc, 63);
            const float aa = g - bc + gi; const float amax = wave_max(aa);
            sW[lane] = expf(aa - amax) * 0.125f;
            if (lane == 0) { sSc[0] = g; sSc[1] = amax; }
        }
        __syncthreads();
        const float g = sSc[0], amax = sSc[1];
        {
            const int j = tid >> 3, dc = tid & 7; const int tok = tok0 + (dir ? T - 1 - (64 * c + j) : 64 * c + j);
            const u32x4 kw = *(const u32x4*)(Y2 + (size_t)tok * 3328 + 512 + h * 64 + dc * 8); const float wj = sW[j];
            LAS bf16* kp = kT + (dc * 8) * 72 + j;
            kp[0] = (bf16)f2bf(bflo(kw.x) * wj); kp[72] = (bf16)f2bf(bfhi(kw.x) * wj); kp[144] = (bf16)f2bf(bflo(kw.y) * wj); kp[216] = (bf16)f2bf(bfhi(kw.y) * wj);
            kp[288] = (bf16)f2bf(bflo(kw.z) * wj); kp[360] = (bf16)f2bf(bfhi(kw.z) * wj); kp[432] = (bf16)f2bf(bflo(kw.w) * wj); kp[504] = (bf16)f2bf(bfhi(kw.w) * wj);
#pragma unroll
            for (int q = 0; q < 2; ++q) {
                const int p = tid + q * 512, jv = p >> 4, cc = p & 15; const int tokv = tok0 + (dir ? T - 1 - (64 * c + jv) : 64 * c + jv);
                const u32x4 vw = *(const u32x4*)(Y2 + (size_t)tokv * 3328 + 1024 + h * 128 + cc * 8);
                LAS bf16* vp = vT + (cc * 8) * 72 + jv;
                vp[0] = (bf16)(vw.x & 0xffffu); vp[72] = (bf16)(vw.x >> 16); vp[144] = (bf16)(vw.y & 0xffffu); vp[216] = (bf16)(vw.y >> 16);
                vp[288] = (bf16)(vw.z & 0xffffu); vp[360] = (bf16)(vw.z >> 16); vp[432] = (bf16)(vw.w & 0xffffu); vp[504] = (bf16)(vw.w >> 16);
            }
        }
        __syncthreads();
        f32x16 kv;
#pragma unroll
        for (int r = 0; r < 16; ++r) kv[r] = 0.f;
#pragma unroll
        for (int lc = 0; lc < 4; ++lc) {
            const bf16x8 A = *(const LAS bf16x8*)(kT + (32 * dt + r32) * 72 + 16 * lc + 8 * hi);
            const bf16x8 B = *(const LAS bf16x8*)(vT + (32 * et + r32) * 72 + 16 * lc + 8 * hi);
            kv = mfma32(A, B, kv);
        }
        float kn = 0.f;
        if (wave == 0) {
#pragma unroll
            for (int q = 0; q < 8; ++q) { const u32x4 w = *(const LAS u32x4*)(kT + lane * 72 + q * 8);
                kn += (bflo(w.x) + bfhi(w.x)) + (bflo(w.y) + bfhi(w.y)) + (bflo(w.z) + bfhi(w.z)) + (bflo(w.w) + bfhi(w.w)); }
        }
        const int cpi = cpbase + c;
        bf16* cp = CP + (size_t)cpi * 8192 + (size_t)(32 * et + r32) * 64 + 32 * dt + 4 * hi;
#pragma unroll
        for (int g4 = 0; g4 < 4; ++g4) { u32x2 w; w.x = pk2(C[4 * g4], C[4 * g4 + 1]); w.y = pk2(C[4 * g4 + 2], C[4 * g4 + 3]); *(u32x2*)(cp + 8 * g4) = w; }
        if (wave == 0) { NP[(size_t)cpi * 64 + lane] = nst; if (lane == 0) MP[cpi] = mst; }
        const float mnew = fmaxf(g + mst, amax); const float so = expf(g + mst - mnew), sn = expf(amax - mnew);
#pragma unroll
        for (int r = 0; r < 16; ++r) C[r] = so * C[r] + sn * kv[r];
        nst = so * nst + sn * kn; mst = mnew;
        __syncthreads();
    }
    if (!isS) {
        const size_t sb = (size_t)((b * 2 + dir) * 8 + h);
        float* Co = a.out + OUT_C + sb * 8192;
#pragma unroll
        for (int r = 0; r < 16; ++r) Co[(size_t)(32 * dt + (r & 3) + 8 * (r >> 2) + 4 * hi) * 128 + 32 * et + r32] = C[r];
        if (wave == 0) { a.out[OUT_N + sb * 64 + lane] = nst; if (lane == 0) a.out[OUT_M + sb] = mst; }
    }
}
__device__ __forceinline__ void phase_scan(const Args& a, LAS unsigned char* lds) {
    const int G = gridDim.x;
    for (int Lx = lbid(); Lx < 1024; Lx += G) {
        const int s = Lx >> 8, i = Lx & 255;
        if (i < 128) { if (s == 0) scan_unit(a, lds, true, i >> 4, (i >> 1) & 7, i & 1); }
        else { const int v = (i - 128) * 4 + s; scan_unit(a, lds, false, v >> 4, (v >> 1) & 7, v & 1); }
    }
}

__device__ __forceinline__ void intra_unit(const Args& a, LAS unsigned char* lds, bool isS, int b, int h, int c) {
    unsigned char* ws = a.ws;
    const int tid = ltid(), lane = tid & 63, wave = tid >> 6, r32 = lane & 31, hi = lane >> 5;
    const bf16* Y2 = (const bf16*)(ws + WS_Y);
    const bf16* CP = (const bf16*)(a.out + OUT_Y); const float* NP = (const float*)(ws + WS_NP); const float* MP = (const float*)(ws + WS_MP);
    bf16* HS = (bf16*)(ws + WS_HS);
    const float* bg = a.in[26];
    const int nc = isS ? 16 : 4, tok0 = (isS ? NPROMPT + b * 1024 : b * 256) + 64 * c;
    const int cpb = isS ? 2048 + ((b * 8 + h) * 2) * 16 : ((b * 8 + h) * 2) * 4;
    LAS bf16* sQ = (LAS bf16*)lds; LAS bf16* sK = sQ + 64 * 72; LAS bf16* sVT = sK + 64 * 72;
    LAS float* sB = (LAS float*)(sVT + 128 * 72); LAS float* sU = sB + 128; LAS float* sMT = sU + 128; LAS float* sNP = sMT + 128; LAS float* sMp = sNP + 128; LAS float* sRed = sMp + 2;
    {
        const int l = tid >> 3, dc = tid & 7; const bf16* yr = Y2 + (size_t)(tok0 + l) * 3328 + h * 64 + dc * 8;
        *(LAS u32x4*)(sQ + l * 72 + dc * 8) = *(const u32x4*)yr;
        const u32x4 kw = *(const u32x4*)(yr + 512);
        u32x4 ks; ks.x = pk2(bflo(kw.x) * 0.125f, bfhi(kw.x) * 0.125f); ks.y = pk2(bflo(kw.y) * 0.125f, bfhi(kw.y) * 0.125f);
        ks.z = pk2(bflo(kw.z) * 0.125f, bfhi(kw.z) * 0.125f); ks.w = pk2(bflo(kw.w) * 0.125f, bfhi(kw.w) * 0.125f);
        *(LAS u32x4*)(sK + l * 72 + dc * 8) = ks;
#pragma unroll
        for (int q = 0; q < 2; ++q) {
            const int p = tid + q * 512, lv = p >> 4, cc = p & 15;
            const u32x4 vw = *(const u32x4*)(Y2 + (size_t)(tok0 + lv) * 3328 + 1024 + h * 128 + cc * 8);
            LAS bf16* vp = sVT + (cc * 8) * 72 + lv;
            vp[0] = (bf16)(vw.x & 0xffffu); vp[72] = (bf16)(vw.x >> 16); vp[144] = (bf16)(vw.y & 0xffffu); vp[216] = (bf16)(vw.y >> 16);
            vp[288] = (bf16)(vw.z & 0xffffu); vp[360] = (bf16)(vw.z >> 16); vp[432] = (bf16)(vw.w & 0xffffu); vp[504] = (bf16)(vw.w >> 16);
        }
    }
    if (wave < 2) {
        const int dir = wave; const int l = dir ? 63 - lane : lane;
        const int cpi = cpb + dir * nc + (dir ? nc - 1 - c : c);
        const bf16* yr = Y2 + (size_t)(tok0 + l) * 3328 + 3072;
        const float gi = bf2f(yr[(2 * dir) * 8 + h]) + bg[(2 * dir) * 8 + h], gf = bf2f(yr[(2 * dir + 1) * 8 + h]) + bg[(2 * dir + 1) * 8 + h];
        const float bc = scan_sum(log_sigmoid(gf), lane);
        const float u = gi - bc; const float mx = scan_max(u, lane);
        const float mp = MP[cpi];
        sB[dir * 64 + l] = bc; sU[dir * 64 + l] = u; sMT[dir * 64 + l] = bc + fmaxf(mp, mx);
        sNP[dir * 64 + lane] = NP[(size_t)cpi * 64 + lane];
        if (lane == 0) sMp[dir] = mp;
    }
    __syncthreads();
    const int lt = wave & 1, et = wave >> 1, l = 32 * lt + r32;
    const int prow = (r32 & ~12) | (((r32 >> 2) & 1) << 3) | (((r32 >> 3) & 1) << 2);
    bf16x8 qf[4];
#pragma unroll
    for (int dc = 0; dc < 4; ++dc) qf[dc] = *(const LAS bf16x8*)(sQ + l * 72 + 16 * dc + 8 * hi);
    f32x16 hsum;
#pragma unroll
    for (int r = 0; r < 16; ++r) hsum[r] = 0.f;
#pragma unroll 1
    for (int dir = 0; dir < 2; ++dir) {
        const int cpi = cpb + dir * nc + (dir ? nc - 1 - c : c);
        f32x16 s0, s1, nacc, iacc;
#pragma unroll
        for (int r = 0; r < 16; ++r) { s0[r] = 0.f; s1[r] = 0.f; nacc[r] = 0.f; iacc[r] = 0.f; }
#pragma unroll
        for (int dc = 0; dc < 4; ++dc) {
            const bf16x8 k0 = *(const LAS bf16x8*)(sK + prow * 72 + 16 * dc + 8 * hi);
            const bf16x8 k1 = *(const LAS bf16x8*)(sK + (32 + prow) * 72 + 16 * dc + 8 * hi);
            s0 = mfma32(k0, qf[dc], s0); s1 = mfma32(k1, qf[dc], s1);
        }
        const bf16* cp = CP + (size_t)cpi * 8192 + (size_t)(32 * et + r32) * 64 + 8 * hi;
#pragma unroll
        for (int dc = 0; dc < 4; ++dc) { const bf16x8 cf = *(const bf16x8*)(cp + 16 * dc); iacc = mfma32(cf, qf[dc], iacc); }
        const float bl = sB[dir * 64 + l], mtl = sMT[dir * 64 + l], mp = sMp[dir];
        const float base = bl - mtl;
        float dsum = 0.f;
#pragma unroll
        for (int r = 0; r < 16; ++r) {
            const int si0 = 16 * (r >> 3) + 8 * hi + (r & 7), si1 = 32 + si0;
            const bool ok0 = dir ? (si0 >= l) : (si0 <= l), ok1 = dir ? (si1 >= l) : (si1 <= l);
            const float e0 = __expf(base + sU[dir * 64 + si0]), e1 = __expf(base + sU[dir * 64 + si1]);
            s0[r] = ok0 ? s0[r] * e0 : 0.f; s1[r] = ok1 ? s1[r] * e1 : 0.f; dsum += s0[r] + s1[r];
        }
        bf16x8 pf[4];
        pf[0] = pack8(s0[0], s0[1], s0[2], s0[3], s0[4], s0[5], s0[6], s0[7]); pf[1] = pack8(s0[8], s0[9], s0[10], s0[11], s0[12], s0[13], s0[14], s0[15]);
        pf[2] = pack8(s1[0], s1[1], s1[2], s1[3], s1[4], s1[5], s1[6], s1[7]); pf[3] = pack8(s1[8], s1[9], s1[10], s1[11], s1[12], s1[13], s1[14], s1[15]);
#pragma unroll
        for (int kc = 0; kc < 4; ++kc) { const bf16x8 v = *(const LAS bf16x8*)(sVT + (32 * et + r32) * 72 + 16 * kc + 8 * hi); nacc = mfma32(v, pf[kc], nacc); }
        float qn = 0.f;
#pragma unroll
        for (int q = 0; q < 4; ++q) {
            const u32x4 w = *(const LAS u32x4*)(sQ + l * 72 + 32 * hi + 8 * q); const LAS float* np = sNP + dir * 64 + 32 * hi + 8 * q;
            qn += bflo(w.x) * np[0] + bfhi(w.x) * np[1] + bflo(w.y) * np[2] + bfhi(w.y) * np[3] + bflo(w.z) * np[4] + bfhi(w.z) * np[5] + bflo(w.w) * np[6] + bfhi(w.w) * np[7];
        }
        qn += __shfl_xor(qn, 32); dsum += __shfl_xor(dsum, 32);
        const float inter = expf(bl + mp - mtl);
        const float den = dsum + inter * qn;
        const float inv = 1.f / fmaxf(fabsf(den), expf(-mtl));
#pragma unroll
        for (int r = 0; r < 16; ++r) hsum[r] += (nacc[r] + inter * iacc[r]) * inv;
    }
    float ss = 0.f;
#pragma unroll
    for (int r = 0; r < 16; ++r) ss += hsum[r] * hsum[r];
    ss += __shfl_xor(ss, 32);
    if (hi == 0) sRed[et * 64 + l] = ss;
    __syncthreads();
    const float tot = (sRed[l] + sRed[64 + l]) + (sRed[128 + l] + sRed[192 + l]);
    const float rstd = rsqrtf(tot * (1.f / 128.f) + RMS_EPS);
    const float* gn = a.in[27];
    const bf16* orow = Y2 + (size_t)(tok0 + l) * 3328 + 2048 + h * 128 + 32 * et + 4 * hi;
    bf16* hrow = HS + (size_t)(tok0 + l) * 1024 + h * 128 + 32 * et + 4 * hi;
#pragma unroll
    for (int g4 = 0; g4 < 4; ++g4) {
        const u32x2 ow = *(const u32x2*)(orow + 8 * g4); const f32x4 gv = *(const f32x4*)(gn + 32 * et + 4 * hi + 8 * g4);
        const float o0 = bflo(ow.x), o1 = bfhi(ow.x), o2 = bflo(ow.y), o3 = bfhi(ow.y);
        u32x2 w;
        w.x = pk2(hsum[4 * g4] * rstd * gv.x / (1.f + __expf(-o0)), hsum[4 * g4 + 1] * rstd * gv.y / (1.f + __expf(-o1)));
        w.y = pk2(hsum[4 * g4 + 2] * rstd * gv.z / (1.f + __expf(-o2)), hsum[4 * g4 + 3] * rstd * gv.w / (1.f + __expf(-o3)));
        *(u32x2*)(hrow + 8 * g4) = w;
    }
    __syncthreads();
}
__device__ __forceinline__ void phase_intra(const Args& a, LAS unsigned char* lds) {
    const int G = gridDim.x;
    for (int U = lbid(); U < 2048; U += G) {
        if (U < 1024) intra_unit(a, lds, false, U >> 5, (U >> 2) & 7, U & 3);
        else { const int v = U - 1024; intra_unit(a, lds, true, v >> 7, (v >> 4) & 7, v & 15); }
    }
}

template <int M, int N, int K, class Epi>
__device__ __forceinline__ void run_gemm(LAS unsigned char* lds, const bf16* A, const bf16* Bt, const Epi& E) {
    pg8::Gemm g{A, Bt, M, N, K}; pg8::StaticOrder S; S.init(M, N, (int)gridDim.x, lbid());
    pg8::gemm_phase<Epi, pg8::StaticOrder, true, true>((PG8_LAS unsigned char*)lds, g, S, E);
}
template <int N, int K>
__device__ __forceinline__ void gemm_plain(LAS unsigned char* lds, unsigned char* ws, size_t offA, size_t offB, size_t offO, int dummy) {
    pg8::EpiBf16<0> E{(bf16*)(ws + offO), N, nullptr, 0, 0, 1.f};
    run_gemm<MTOK, N, K>(lds, (const bf16*)(ws + offA), (const bf16*)(ws + offB), E);
}
template <int K>
__device__ __forceinline__ void gemm_gate(const Args& a, LAS unsigned char* lds, unsigned char* ws, size_t offA, size_t offB, bool fromInput, int L, int goff) {
    float* X = (float*)(ws + WS_X);
    EpiGate E{fromInput ? a.in[0] : X, fromInput ? a.in[1] : X + (size_t)NPROMPT * 1024, X, (const float*)(ws + WS_MOD) + (size_t)L * 9 * 6144 + goff};
    run_gemm<MTOK, 1024, K>(lds, (const bf16*)(ws + offA), (const bf16*)(ws + offB), E);
}

__global__ void __launch_bounds__(NTHREADS, 2) fwd_kernel(Args a) {
    extern __shared__ __attribute__((aligned(16))) unsigned char lds_raw[];
    LAS unsigned char* lds = (LAS unsigned char*)lds_raw;
    const int lo = a.ph_lo, hi = a.ph_hi;
    if (threadIdx.x < 16) ((LAS unsigned*)(lds + LDSCTL_OFF))[threadIdx.x] = 0u;
    __syncthreads();
    XcdBarrier bar = xcd_barrier_post((unsigned*)(a.ws + WS_BAR), (volatile LAS unsigned*)(lds + LDSCTL_OFF) + 8);
#define PHASE(k, ...) if (lo <= (k) && (k) < hi) { unsigned char* ws = a.ws; asm volatile("" : "+s"(ws)); __VA_ARGS__; if ((k) + 1 < hi) { if ((k) == 0) cg::this_grid().sync(); else xcd_barrier(bar); } }
    PHASE(0, phase_prep(a, lds))
    PHASE(1, phase_rowwise(a, 1))
    PHASE(2, (gemm_plain<2048, 1024>(lds, ws, WS_H, WS_W_INAB, WS_Y, 0)))
    PHASE(3, phase_split(a))
    PHASE(4, { gemm_plain<768, 256>(lds, ws, WS_CQN, WS_W_UQ, WS_QA, 0);
               pg8::EpiBf16<0> E{(bf16*)(ws + WS_KVA), 1024, nullptr, 0, 0, 1.f};
               run_gemm<KVROWS, 1024, 256>(lds, (const bf16*)(ws + WS_CKVA), (const bf16*)(ws + WS_W_UKV), E); })
    PHASE(5, phase_attn(a, lds))
    PHASE(6, gemm_gate<1024>(a, lds, ws, WS_MERGED, WS_W_OUTAB, true, 0, 2048))
    PHASE(7, phase_rowwise(a, 7))
    PHASE(8, { EpiSwiGLU E{(bf16*)(ws + WS_HID)}; run_gemm<MTOK, 5632, 1024>(lds, (const bf16*)(ws + WS_H), (const bf16*)(ws + WS_W_FFI), E); })
    PHASE(9, gemm_gate<2816>(a, lds, ws, WS_HID, WS_W_FFO, false, 0, 5120))
    PHASE(10, phase_rowwise(a, 10))
    PHASE(11, (gemm_plain<3328, 1024>(lds, ws, WS_H, WS_W_INC, WS_Y, 0)))
    PHASE(12, phase_scan(a, lds))
    PHASE(13, phase_intra(a, lds))
    PHASE(14, gemm_gate<1024>(a, lds, ws, WS_HS, WS_W_OUTC, false, 1, 2048))
    PHASE(15, phase_rowwise(a, 15))
    PHASE(16, { EpiSwiGLU E{(bf16*)(ws + WS_HID)}; run_gemm<MTOK, 5632, 1024>(lds, (const bf16*)(ws + WS_H), (const bf16*)(ws + WS_W_FFI) + (size_t)5632 * 1024, E); })
    PHASE(17, gemm_gate<2816>(a, lds, ws, WS_HID, WS_W_FFO + (size_t)1024 * 2816 * 2, false, 1, 5120))
    PHASE(18, phase_rowwise(a, 18))
#undef PHASE
}

#ifndef MK_COOP
#define MK_COOP 1
#endif
constexpr int NPHASES = 19;
extern "C" void kernel_launch(void* const* d_in, const int* in_sizes, int n_in, void* d_out, int out_size, void* d_ws, size_t ws_size, hipStream_t stream) {
    static int grid = 0;
    if (grid == 0) {
        if (n_in != 30 || ws_size < WS_END) { fprintf(stderr, "kernel_launch: unexpected n_in %d / ws_size %zu\n", n_in, ws_size); grid = -1; return; }
        int dev = 0, cus = 0, per_cu = 0;
        hipGetDevice(&dev); hipDeviceGetAttribute(&cus, hipDeviceAttributeMultiprocessorCount, dev);
        if (hipFuncSetAttribute((const void*)fwd_kernel, hipFuncAttributeMaxDynamicSharedMemorySize, LDS_BYTES) != hipSuccess) { fprintf(stderr, "kernel_launch: hipFuncSetAttribute failed\n"); grid = -1; return; }
        if (hipOccupancyMaxActiveBlocksPerMultiprocessor(&per_cu, (const void*)fwd_kernel, NTHREADS, LDS_BYTES) != hipSuccess || per_cu < 1) per_cu = 1;
        (void)hipGetLastError();
        grid = cus * 1;
    }
    if (grid < 0) return;
    (void)hipMemsetAsync((char*)d_ws + WS_BAR, 0, WS_BAR_BYTES, stream);
    Args a{};
    for (int i = 0; i < 30; ++i) a.in[i] = (const float*)d_in[i];
    a.out = (float*)d_out; a.ws = (unsigned char*)d_ws;
#if MK_COOP
    a.ph_lo = 0; a.ph_hi = NPHASES;
    void* args[] = {&a};
    hipError_t e = hipLaunchCooperativeKernel((const void*)fwd_kernel, dim3(grid), dim3(NTHREADS), args, LDS_BYTES, stream);
    if (e != hipSuccess) fprintf(stderr, "cooperative launch failed: %s (grid %d)\n", hipGetErrorString(e), grid);
#else
    for (int ph = 0; ph < NPHASES; ++ph) {
        a.ph_lo = ph; a.ph_hi = ph + 1;
        hipLaunchKernelGGL(fwd_kernel, dim3(grid), dim3(NTHREADS), LDS_BYTES, stream, a);
    }
#endif
}
```

```cpp
#include <hip/hip_runtime.h>
#include <hip/hip_cooperative_groups.h>
#include <cstdio>
#include <cstdint>
namespace cg = cooperative_groups;
__device__ __forceinline__ int ltid() { int t = threadIdx.x; asm volatile("" : "+v"(t)); return t; }
__device__ __forceinline__ int lbid() { int b = blockIdx.x; asm volatile("" : "+s"(b)); return b; }
#define MK_COOP 1
namespace pg8 {
#define PG8_LAS __attribute__((address_space(3)))
typedef unsigned short bf16_t;
typedef short bf16x8 __attribute__((ext_vector_type(8)));
typedef float f32x4 __attribute__((ext_vector_type(4)));
typedef unsigned u32x4 __attribute__((ext_vector_type(4)));
constexpr int BM = 256, BK = 64, HALF = 128, HTB = HALF * BK * 2  , STAGE_BYTES = 8 * HTB, NXCD = 8, WGM = 8;

__host__ __device__ __forceinline__ int lds_byte(int r, int c) { const int st = (r >> 4) * 2 + (c >> 5), rr = r & 15, cc = c & 31, ob = rr * 64 + cc * 2; return st * 1024 + (ob ^ (((ob >> 9) & 1) << 5)); }
__host__ __device__ __forceinline__ void stage_rc(int b, int& R, int& C) { const int st = b / 1024, sb = b % 1024, swz = sb ^ (((sb >> 9) & 1) << 5); R = (st >> 1) * 16 + swz / 64; C = (st & 1) * 32 + (swz % 64) / 2; }
__host__ __device__ __forceinline__ int perm32(int rho) { const int n = rho >> 4, i = rho & 15; return 8 * (i >> 2) + 4 * n + (i & 3); }

struct Unit { int pm, pn; };
struct Gemm { const bf16_t* A; const bf16_t* Bt; int M, N, K; };

struct StaticOrder {
    int nM, nN, nwg, G, c;
    __host__ __device__ void init(int M, int N, int G_, int c_) { nM = M / BM; nN = N / BM; nwg = nM * nN; G = G_; c = c_; }
    __host__ __device__ bool next(int i, Unit& u) const {
        const long L = (long)i * G + c; if (L >= nwg) return false;
        int wgid = (int)L; { const int q = nwg / NXCD, r = nwg % NXCD, xcd = wgid % NXCD, off = wgid / NXCD; wgid = (xcd < r ? xcd * (q + 1) : r * (q + 1) + (xcd - r) * q) + off; }
        const int nig = WGM * nN, gid = wgid / nig, fm = gid * WGM, gsz = (nM - fm) < WGM ? (nM - fm) : WGM;
        u.pm = fm + ((wgid % nig) % gsz); u.pn = (wgid % nig) / gsz; return true;
    }
    __device__ __forceinline__ void a_ready(const Unit&) const {}
    __device__ __forceinline__ void done(const Unit&) const {}
};

__device__ __forceinline__ unsigned cvt_pk_bf16(float lo, float hi) { unsigned r; asm volatile("v_cvt_pk_bf16_f32 %0, %1, %2" : "=v"(r) : "v"(lo), "v"(hi)); return r; }
typedef float f32x2 __attribute__((ext_vector_type(2)));
__device__ __forceinline__ f32x2 gelu_pk(f32x2 v) {
    const f32x2 av = __builtin_elementwise_abs(v), d = av * 0.2316418882f + 1.0f;
    f32x2 t; t.x = __builtin_amdgcn_rcpf(d.x); t.y = __builtin_amdgcn_rcpf(d.y);
    f32x2 q = t * 0.5307027145f + (-0.7265760135f); q = q * t + 0.7107068705f; q = q * t + (-0.142248368f); q = q * t + 0.127414796f; q = q * t;
    const f32x2 s = (v * v) * (-0.72134752044f);
    f32x2 e; e.x = __builtin_amdgcn_exp2f(s.x); e.y = __builtin_amdgcn_exp2f(s.y);
    const f32x2 m = v * (q * e), r = v - m;
    f32x2 o; o.x = v.x < 0.f ? m.x : r.x; o.y = v.y < 0.f ? m.y : r.y; return o;
}

template <int ACT  > struct EpiBf16 {
    static constexpr bool PERM = true, AFTER_DRAIN = false; static_assert(ACT == 0 || ACT == 1, "EpiBf16: ACT is 0 (none) or 1 (gelu_pk)");
    bf16_t* O; int ldc; const float* bias; int split_cols; size_t split_stride; float scale0;
    __device__ __forceinline__ void operator()(const f32x4 (&acc)[2][2][4][2], const Unit& u, int wr, int wc, int fr, int fq) const {
        const int row0 = u.pm * BM + wr * 64 + fr; int colt = u.pn * BM; bf16_t* base = O;
        float sc = 1.f; if (split_cols) { const int t = colt / split_cols; base += (size_t)t * split_stride; colt -= t * split_cols; if (t == 0) sc = scale0; }
        const int col0 = colt + wc * 32 + 8 * fq, bcol0 = u.pn * BM + wc * 32 + 8 * fq;
        f32x4 bv[2][2];
#pragma unroll
        for (int bj = 0; bj < 2; ++bj)
#pragma unroll
            for (int n = 0; n < 2; ++n) bv[bj][n] = bias ? *(const f32x4*)(bias + bcol0 + bj * HALF + 4 * n) : (f32x4){0.f, 0.f, 0.f, 0.f};
#pragma unroll
        for (int ai = 0; ai < 2; ++ai)
#pragma unroll
            for (int m = 0; m < 4; ++m) { bf16_t* rowp = base + (size_t)(row0 + ai * HALF + m * 16) * ldc + col0;
#pragma unroll
                for (int bj = 0; bj < 2; ++bj) { f32x4 v0 = acc[ai][bj][m][0] + bv[bj][0], v1 = acc[ai][bj][m][1] + bv[bj][1];
                    if (ACT == 1) { f32x2 a = gelu_pk((f32x2){v0[0], v0[1]}), b = gelu_pk((f32x2){v0[2], v0[3]}), c = gelu_pk((f32x2){v1[0], v1[1]}), d = gelu_pk((f32x2){v1[2], v1[3]});
                        v0 = (f32x4){a.x, a.y, b.x, b.y}; v1 = (f32x4){c.x, c.y, d.x, d.y}; }
                    v0 = v0 * sc; v1 = v1 * sc; u32x4 w; w.x = cvt_pk_bf16(v0[0], v0[1]); w.y = cvt_pk_bf16(v0[2], v0[3]); w.z = cvt_pk_bf16(v1[0], v1[1]); w.w = cvt_pk_bf16(v1[2], v1[3]);
                    *(u32x4*)(rowp + bj * HALF) = w; } }
    }
};
template <class Epi, class Sched, bool ALIGN_EPI = false, bool SP2 = false>
__device__ __forceinline__ void gemm_phase(PG8_LAS unsigned char* lds, const Gemm g, const Sched& S, const Epi& E) {
    const int tid = ltid(), wid = __builtin_amdgcn_readfirstlane(tid >> 6), lane = tid & 63, wr = wid >> 2, wc = wid & 3, fr = lane & 15, fq = lane >> 4;
    const int K = g.K, nt = K / BK;
    unsigned voffA[2], voffB[2];
#pragma unroll
    for (int i = 0; i < 2; ++i) { int R, C; stage_rc(tid * 16 + i * 8192, R, C); const int Rb = Epi::PERM ? ((R & ~31) + perm32(R & 31)) : R;
        voffA[i] = (unsigned)(R * K + C) * 2u; voffB[i] = (unsigned)(Rb * K + C) * 2u; }
    const size_t kstep = (size_t)(BK * 2);
    const size_t hstep = (size_t)HALF * K * 2;
    const size_t tstep = 2 * hstep;
    const unsigned ldsw = (unsigned)wid * 1024u;
    const int aoff = lds_byte(wr * 64 + fr, fq * 8), boff = lds_byte(wc * 32 + fr, fq * 8);
#define PG8_SA(b, h) (((b) * 2 + (h)) * HTB)
#define PG8_SB(b, h) ((4 + (b) * 2 + (h)) * HTB)
#define PG8_STAGE(bufoff, gbase, voff) do { _Pragma("unroll") for (int _i = 0; _i < 2; ++_i) \
        __builtin_amdgcn_global_load_lds((const unsigned*)((const char*)(gbase) + (voff)[_i]), (PG8_LAS unsigned*)(lds + (bufoff) + ldsw + _i * 8192), 16, 0, 0); } while (0)
#define PG8_LDA(dst, b, h) do { _Pragma("unroll") for (int m = 0; m < 4; ++m) _Pragma("unroll") for (int k = 0; k < 2; ++k) dst[m][k] = *(const PG8_LAS bf16x8*)(lds + PG8_SA(b, h) + aoff + m * 2048 + k * 1024); } while (0)
#define PG8_LDB(dst, b, h) do { _Pragma("unroll") for (int n = 0; n < 2; ++n) _Pragma("unroll") for (int k = 0; k < 2; ++k) dst[n][k] = *(const PG8_LAS bf16x8*)(lds + PG8_SB(b, h) + boff + n * 2048 + k * 1024); } while (0)
#define PG8_MMA(ai, bj, At, Bt) do { __builtin_amdgcn_s_setprio(1); _Pragma("unroll") for (int m = 0; m < 4; ++m) _Pragma("unroll") for (int n = 0; n < 2; ++n) _Pragma("unroll") for (int k = 0; k < 2; ++k) \
        acc[ai][bj][m][n] = __builtin_amdgcn_mfma_f32_16x16x32_bf16(Bt[n][k], At[m][k], acc[ai][bj][m][n], 0, 0, 0); __builtin_amdgcn_s_setprio(0); } while (0)
#define PG8_WAIT_V(n) asm volatile("s_waitcnt vmcnt(" #n ")" ::: "memory")
#define PG8_WAIT_L(n) asm volatile("s_waitcnt lgkmcnt(" #n ")" ::: "memory")
#define PG8_BAR __builtin_amdgcn_s_barrier()
#define PG8_SCHED __builtin_amdgcn_sched_barrier(0)
    Unit cur, nxt; int ui = 0;
    if (!S.next(0, cur)) return;
    f32x4 acc[2][2][4][2];
#pragma unroll
    for (int a = 0; a < 2; ++a)
#pragma unroll
        for (int b = 0; b < 2; ++b)
#pragma unroll
            for (int m = 0; m < 4; ++m)
#pragma unroll
                for (int n = 0; n < 2; ++n) acc[a][b][m][n] = (f32x4){0.f, 0.f, 0.f, 0.f};
    bf16x8 At[4][2], B0[2][2], B1[2][2];
    const char* cA = (const char*)g.A + (size_t)cur.pm * tstep; const char* cB = (const char*)g.Bt + (size_t)cur.pn * tstep;
    S.a_ready(cur);
    if constexpr (SP2) {
        PG8_STAGE(PG8_SB(0, 0), cB, voffB); PG8_STAGE(PG8_SB(0, 1), cB + hstep, voffB); PG8_STAGE(PG8_SA(0, 0), cA, voffA); PG8_STAGE(PG8_SA(0, 1), cA + hstep, voffA);
        if (wr == 1) PG8_BAR;
        PG8_WAIT_V(2); PG8_BAR;
        PG8_STAGE(PG8_SB(1, 0), cB + kstep, voffB); PG8_STAGE(PG8_SA(1, 0), cA + kstep, voffA); PG8_STAGE(PG8_SB(1, 1), cB + hstep + kstep, voffB);
        PG8_WAIT_V(6); PG8_BAR;
    } else {
        PG8_STAGE(PG8_SB(0, 0), cB, voffB); PG8_STAGE(PG8_SA(0, 0), cA, voffA); PG8_STAGE(PG8_SB(0, 1), cB + hstep, voffB); PG8_STAGE(PG8_SA(0, 1), cA + hstep, voffA);
        if (wr == 1) PG8_BAR;
        PG8_WAIT_V(4); PG8_BAR;
        PG8_STAGE(PG8_SB(1, 0), cB + kstep, voffB); PG8_STAGE(PG8_SA(1, 0), cA + kstep, voffA); PG8_STAGE(PG8_SB(1, 1), cB + hstep + kstep, voffB);
        PG8_WAIT_V(6); PG8_BAR;
    }
    for (;;) {
        const bool has_next = S.next(ui + 1, nxt);
        const char* nA = has_next ? (const char*)g.A + (size_t)nxt.pm * tstep : cA; const char* nB = has_next ? (const char*)g.Bt + (size_t)nxt.pn * tstep : cB;
        for (int t = 0; t < nt; t += 2) {
            const bool last = (t == nt - 2);
            const char* a1 = cA + (size_t)(t + 1) * kstep;
            const char* a2 = last ? nA : cA + (size_t)(t + 2) * kstep; const char* b2 = last ? nB : cB + (size_t)(t + 2) * kstep;
            const char* a3 = a2 + kstep; const char* b3 = b2 + kstep;
            if (last && has_next) S.a_ready(nxt);
            if constexpr (SP2) {
            PG8_LDB(B0, 0, 0); PG8_LDB(B1, 0, 1); PG8_SCHED; PG8_LDA(At, 0, 0); PG8_STAGE(PG8_SA(1, 1), a1 + hstep, voffA);
            PG8_WAIT_V(8); PG8_WAIT_L(0); PG8_BAR; PG8_MMA(0, 0, At, B0); PG8_MMA(0, 1, At, B1); PG8_BAR; PG8_SCHED;
            PG8_LDA(At, 0, 1); PG8_STAGE(PG8_SB(0, 0), b2, voffB); PG8_STAGE(PG8_SB(0, 1), b2 + hstep, voffB); PG8_STAGE(PG8_SA(0, 0), a2, voffA);
            PG8_WAIT_V(8); PG8_WAIT_L(0); PG8_BAR; PG8_MMA(1, 0, At, B0); PG8_MMA(1, 1, At, B1); PG8_BAR; PG8_SCHED;
            PG8_LDB(B0, 1, 0); PG8_LDB(B1, 1, 1); PG8_SCHED; PG8_LDA(At, 1, 0); PG8_STAGE(PG8_SA(0, 1), a2 + hstep, voffA);
            PG8_WAIT_V(8); PG8_WAIT_L(0); PG8_BAR; PG8_MMA(0, 0, At, B0); PG8_MMA(0, 1, At, B1); PG8_BAR; PG8_SCHED;
            PG8_LDA(At, 1, 1); PG8_STAGE(PG8_SB(1, 0), b3, voffB); PG8_STAGE(PG8_SB(1, 1), b3 + hstep, voffB); PG8_STAGE(PG8_SA(1, 0), a3, voffA);
            PG8_WAIT_V(8); PG8_WAIT_L(0); PG8_BAR; PG8_MMA(1, 0, At, B0); PG8_MMA(1, 1, At, B1); PG8_BAR; PG8_SCHED;
            } else {
            PG8_LDB(B0, 0, 0); PG8_SCHED; PG8_LDA(At, 0, 0); PG8_STAGE(PG8_SA(1, 1), a1 + hstep, voffA);
            PG8_WAIT_L(8); PG8_BAR; PG8_WAIT_L(0); PG8_MMA(0, 0, At, B0); PG8_BAR; PG8_SCHED;
            PG8_LDB(B1, 0, 1); PG8_STAGE(PG8_SB(0, 0), b2, voffB);
            PG8_BAR; PG8_WAIT_L(0); PG8_MMA(0, 1, At, B1); PG8_BAR;
            PG8_LDA(At, 0, 1); PG8_STAGE(PG8_SA(0, 0), a2, voffA);
            PG8_BAR; PG8_WAIT_L(0); PG8_MMA(1, 0, At, B0); PG8_BAR; PG8_SCHED;
            PG8_STAGE(PG8_SB(0, 1), b2 + hstep, voffB);
            PG8_WAIT_V(6); PG8_BAR; PG8_MMA(1, 1, At, B1); PG8_BAR;
            PG8_LDB(B0, 1, 0); PG8_SCHED; PG8_LDA(At, 1, 0); PG8_STAGE(PG8_SA(0, 1), a2 + hstep, voffA);
            PG8_WAIT_L(8); PG8_BAR; PG8_WAIT_L(0); PG8_MMA(0, 0, At, B0); PG8_BAR; PG8_SCHED;
            PG8_LDB(B1, 1, 1); PG8_STAGE(PG8_SB(1, 0), b3, voffB);
            PG8_BAR; PG8_WAIT_L(0); PG8_MMA(0, 1, At, B1); PG8_BAR;
            PG8_LDA(At, 1, 1); PG8_STAGE(PG8_SA(1, 0), a3, voffA);
            PG8_BAR; PG8_WAIT_L(0); PG8_MMA(1, 0, At, B0); PG8_BAR; PG8_SCHED;
            PG8_STAGE(PG8_SB(1, 1), b3 + hstep, voffB);
            PG8_WAIT_V(6); PG8_BAR; PG8_MMA(1, 1, At, B1); PG8_BAR;
            }
        }
        if constexpr (ALIGN_EPI) { if (wr == 0) PG8_BAR; }
        if constexpr (!Epi::AFTER_DRAIN) { E(acc, cur, wr, wc, fr, fq); S.done(cur); }
        if (!has_next) break;
#pragma unroll
        for (int a = 0; a < 2; ++a)
#pragma unroll
            for (int b = 0; b < 2; ++b)
#pragma unroll
                for (int m = 0; m < 4; ++m)
#pragma unroll
                    for (int n = 0; n < 2; ++n) acc[a][b][m][n] = (f32x4){0.f, 0.f, 0.f, 0.f};
        cur = nxt; cA = nA; cB = nB; ++ui;
        if constexpr (ALIGN_EPI) { if (wr == 1) PG8_BAR; }
    }
    PG8_WAIT_V(0);
    if constexpr (!ALIGN_EPI) { if (wr == 0) PG8_BAR; }
    PG8_BAR;
    if constexpr (Epi::AFTER_DRAIN) { E.fused(acc, cur, wr, wc, fr, fq, lds, wid, lane); S.done(cur); }
#undef PG8_SA
#undef PG8_SB
#undef PG8_STAGE
#undef PG8_LDA
#undef PG8_LDB
#undef PG8_MMA
#undef PG8_WAIT_V
#undef PG8_WAIT_L
#undef PG8_BAR
#undef PG8_SCHED
}
}

#define LAS __attribute__((address_space(3)))
typedef unsigned short bf16;
typedef short bf16x8 __attribute__((ext_vector_type(8)));
typedef float f32x4 __attribute__((ext_vector_type(4)));
typedef float f32x16 __attribute__((ext_vector_type(16)));
typedef unsigned u32x4 __attribute__((ext_vector_type(4)));
typedef unsigned u32x2 __attribute__((ext_vector_type(2)));

constexpr int NTHREADS = 512, NWAVES = 8;
constexpr int LDS_BYTES = 147456;
constexpr int MTOK = 16384, NPROMPT = 8192, KVROWS = 18432;
constexpr float RMS_EPS = 1e-6f;
constexpr size_t MiB = 1u << 20;
constexpr size_t WS_BAR = 768 * 1024, WS_BAR_BYTES = 16384;
constexpr int LDSCTL_OFF = 131072;
constexpr size_t WS_MOD = 0, WS_ROPE8 = 512 * 1024, WS_ROPE16 = WS_ROPE8 + 4096;
constexpr size_t WS_W_INAB = 1 * MiB, WS_W_UQ = 5 * MiB, WS_W_UKV = 5 * MiB + 512 * 1024, WS_W_OUTAB = 6 * MiB, WS_W_FFI = 8 * MiB, WS_W_FFO = 30 * MiB,
                 WS_W_INC = 41 * MiB, WS_W_OUTC = 48 * MiB;
constexpr size_t WS_X = 50 * MiB;
constexpr size_t WS_CQN = 50 * MiB, WS_CKVA = 58 * MiB, WS_KR = 67 * MiB, WS_DQ = 69 * MiB, WS_DK = 85 * MiB, WS_DV = 103 * MiB;
constexpr size_t WS_H = 114 * MiB, WS_Y = 146 * MiB, WS_QA = 121 * MiB, WS_KVA = 146 * MiB, WS_MERGED = 182 * MiB, WS_HID = 146 * MiB;
constexpr size_t WS_NP = 250 * MiB, WS_MP = 251 * MiB, WS_HS = 114 * MiB, WS_END = 256 * MiB;
constexpr size_t OUT_Y = 0, OUT_CKV = 16777216, OUT_KR = 17825792, OUT_DK = 18087936, OUT_DV = 22282240, OUT_C = 26476544, OUT_N = 30670848, OUT_M = 30703616;

struct Args { const float* in[30]; float* out; unsigned char* ws; int ph_lo, ph_hi; };

__device__ __forceinline__ unsigned f2bf(float f) { unsigned u = __float_as_uint(f); return (u + 0x7fffu + ((u >> 16) & 1u)) >> 16; }
__device__ __forceinline__ unsigned pk2(float lo, float hi) { return pg8::cvt_pk_bf16(lo, hi); }
__device__ __forceinline__ float bflo(unsigned w) { return __uint_as_float(w << 16); }
__device__ __forceinline__ float bfhi(unsigned w) { return __uint_as_float(w & 0xffff0000u); }
__device__ __forceinline__ float bf2f(bf16 b) { return __uint_as_float(((unsigned)b) << 16); }
__device__ __forceinline__ float wave_sum(float v) {
#pragma unroll
    for (int o = 1; o < 64; o <<= 1) v += __shfl_xor(v, o);
    return v;
}
__device__ __forceinline__ float wave_max(float v) {
#pragma unroll
    for (int o = 1; o < 64; o <<= 1) v = fmaxf(v, __shfl_xor(v, o));
    return v;
}
__device__ __forceinline__ float scan_sum(float v, int lane) {
#pragma unroll
    for (int o = 1; o < 64; o <<= 1) { float t = __shfl_up(v, o); if (lane >= o) v += t; }
    return v;
}
__device__ __forceinline__ float scan_max(float v, int lane) {
#pragma unroll
    for (int o = 1; o < 64; o <<= 1) { float t = __shfl_up(v, o); if (lane >= o) v = fmaxf(v, t); }
    return v;
}
__device__ __forceinline__ float log_sigmoid(float x) { return fminf(x, 0.f) - log1pf(expf(-fabsf(x))); }
__device__ __forceinline__ f32x16 mfma32(bf16x8 a, bf16x8 b, f32x16 c) { return __builtin_amdgcn_mfma_f32_32x32x16_bf16(a, b, c, 0, 0, 0); }
__device__ __forceinline__ bf16x8 pack8(float a0, float a1, float a2, float a3, float a4, float a5, float a6, float a7) {
    u32x4 w; w.x = pk2(a0, a1); w.y = pk2(a2, a3); w.z = pk2(a4, a5); w.w = pk2(a6, a7); return __builtin_bit_cast(bf16x8, w);
}

struct EpiGate {
    static constexpr bool PERM = true, AFTER_DRAIN = false;
    const float* baseP; const float* baseS; float* out; const float* mod;
    __device__ __forceinline__ void operator()(const pg8::f32x4 (&acc)[2][2][4][2], const pg8::Unit& u, int wr, int wc, int fr, int fq) const {
        const int rowb = u.pm * 256; const int n = rowb < NPROMPT ? 0 : 1 + ((rowb - NPROMPT) >> 10);
        const int row0 = rowb + wr * 64 + fr, col0 = u.pn * 256 + wc * 32 + 8 * fq;
        const float* gp = mod + n * 6144 + col0;
        f32x4 gv[2][2];
#pragma unroll
        for (int bj = 0; bj < 2; ++bj) { gv[bj][0] = *(const f32x4*)(gp + bj * 128); gv[bj][1] = *(const f32x4*)(gp + bj * 128 + 4); }
        const float* bb = rowb < NPROMPT ? baseP + (size_t)row0 * 1024 : baseS + (size_t)(row0 - NPROMPT) * 1024;
#pragma unroll
        for (int ai = 0; ai < 2; ++ai)
#pragma unroll
            for (int m = 0; m < 4; ++m) {
                const size_t ro = (size_t)(ai * 128 + m * 16) * 1024 + col0;
                float* op = out + (size_t)row0 * 1024 + ro;
#pragma unroll
                for (int bj = 0; bj < 2; ++bj) {
                    const f32x4 x0 = *(const f32x4*)(bb + ro + bj * 128), x1 = *(const f32x4*)(bb + ro + bj * 128 + 4);
                    *(f32x4*)(op + bj * 128) = x0 + gv[bj][0] * acc[ai][bj][m][0];
                    *(f32x4*)(op + bj * 128 + 4) = x1 + gv[bj][1] * acc[ai][bj][m][1];
                }
            }
    }
};
struct EpiSwiGLU {
    static constexpr bool PERM = true, AFTER_DRAIN = false;
    bf16* O;
    __device__ __forceinline__ void operator()(const pg8::f32x4 (&acc)[2][2][4][2], const pg8::Unit& u, int wr, int wc, int fr, int fq) const {
        const int row0 = u.pm * 256 + wr * 64 + fr, col0 = u.pn * 128 + wc * 32 + 8 * fq;
#pragma unroll
        for (int ai = 0; ai < 2; ++ai)
#pragma unroll
            for (int m = 0; m < 4; ++m) {
                float hv[8];
#pragma unroll
                for (int n = 0; n < 2; ++n)
#pragma unroll
                    for (int i = 0; i < 4; ++i) { const float av = acc[ai][0][m][n][i], bv = acc[ai][1][m][n][i]; hv[n * 4 + i] = av * bv * __builtin_amdgcn_rcpf(1.f + __expf(-av)); }
                u32x4 w; w.x = pk2(hv[0], hv[1]); w.y = pk2(hv[2], hv[3]); w.z = pk2(hv[4], hv[5]); w.w = pk2(hv[6], hv[7]);
                *(u32x4*)(O + (size_t)(row0 + ai * 128 + m * 16) * 2816 + col0) = w;
            }
    }
};

__device__ __forceinline__ void tr_item(const float* W, int N, bf16* WT, int ldk, int k0, int n0, int drow0, LAS float* scr, int lane) {
#pragma unroll 8
    for (int i = 0; i < 32; ++i) { const int kk = 2 * i + (lane >> 5); scr[kk * 33 + (lane & 31)] = W[(size_t)(k0 + kk) * N + n0 + (lane & 31)]; }
    __builtin_amdgcn_s_waitcnt(0); asm volatile("" ::: "memory");
    const int c = lane & 7;
#pragma unroll
    for (int j = 0; j < 4; ++j) { const int n = (lane >> 3) + 8 * j; const LAS float* s = scr + (8 * c) * 33 + n;
        u32x4 o; o.x = pk2(s[0 * 33], s[1 * 33]); o.y = pk2(s[2 * 33], s[3 * 33]); o.z = pk2(s[4 * 33], s[5 * 33]); o.w = pk2(s[6 * 33], s[7 * 33]);
        *(u32x4*)(WT + (size_t)(drow0 + n) * ldk + k0 + 8 * c) = o; }
    __builtin_amdgcn_s_waitcnt(0); asm volatile("" ::: "memory");
}

__device__ __forceinline__ void phase_prep(const Args& a, LAS unsigned char* lds) {
    const int tid = ltid(), lane = tid & 63, wave = tid >> 6, G = gridDim.x;
    unsigned char* ws = a.ws;
    float* MOD = (float*)(ws + WS_MOD);
    if (lbid() < 192) {
        LAS float* sS = (LAS float*)lds; LAS float* sRed = sS + 1024 * 12;
        for (int idx = tid; idx < 9 * 1024; idx += NTHREADS) { const int n = idx >> 10, k = idx & 1023; const float c = n == 0 ? a.in[10][k] : a.in[9][(n - 1) * 1024 + k]; sS[k * 12 + n] = c / (1.f + expf(-c)); }
        __syncthreads();
        for (int it = lbid(); it < 192; it += G) {
            const int l = it / 96, j0 = (it % 96) * 64, kg = tid >> 6, jl = tid & 63;
            const float* W = a.in[11] + ((size_t)l * 1024 + kg * 128) * 6144 + j0 + jl;
            float acc[9];
#pragma unroll
            for (int n = 0; n < 9; ++n) acc[n] = 0.f;
#pragma unroll 8
            for (int k = 0; k < 128; ++k) {
                const float w = W[(size_t)k * 6144]; const LAS float* s = sS + (kg * 128 + k) * 12;
                const f32x4 s0 = *(const LAS f32x4*)s, s1 = *(const LAS f32x4*)(s + 4); const float s8 = s[8];
                acc[0] += w * s0.x; acc[1] += w * s0.y; acc[2] += w * s0.z; acc[3] += w * s0.w; acc[4] += w * s1.x; acc[5] += w * s1.y; acc[6] += w * s1.z; acc[7] += w * s1.w; acc[8] += w * s8;
            }
#pragma unroll
            for (int n = 0; n < 9; ++n) sRed[(kg * 64 + jl) * 9 + n] = acc[n];
            __syncthreads();
            for (int idx = tid; idx < 576; idx += NTHREADS) { const int n = idx >> 6, j2 = idx & 63; float s = a.in[12][l * 6144 + j0 + j2];
#pragma unroll
                for (int g = 0; g < 8; ++g) s += sRed[(g * 64 + j2) * 9 + n];
                MOD[(l * 9 + n) * 6144 + j0 + j2] = s; }
            __syncthreads();
        }
    }
    __syncthreads();
    if (lbid() == 0) {
        float* R8 = (float*)(ws + WS_ROPE8); float* R16 = (float*)(ws + WS_ROPE16);
        { const int pos = tid >> 3, i = tid & 7; const float fr = (float)pow(10000.0, -(double)i / 8.0); const float ang = (float)pos * fr; R8[tid * 2] = (float)cos((double)ang); R8[tid * 2 + 1] = (float)sin((double)ang); }
        for (int e = tid; e < 1024; e += NTHREADS) { const int pos = e >> 4, i = e & 15; const float fr = (float)pow(10000.0, -(double)i / 16.0); const float ang = (float)pos * fr; R16[e * 2] = (float)cos((double)ang); R16[e * 2 + 1] = (float)sin((double)ang); }
    }
    {
        const int gt = lbid() * NTHREADS + tid, NGT = G * NTHREADS; const u32x4 z = {0u, 0u, 0u, 0u};
        bf16* wukv = (bf16*)(ws + WS_W_UKV);
        for (int i = gt; i < 1024 * 16; i += NGT) *(u32x4*)(wukv + (size_t)(i >> 4) * 256 + 128 + (i & 15) * 8) = z;
        u32x4* p1 = (u32x4*)((bf16*)(ws + WS_W_INAB) + (size_t)1952 * 1024);
        for (int i = gt; i < 12288; i += NGT) p1[i] = z;
        u32x4* p2 = (u32x4*)((bf16*)(ws + WS_W_INC) + (size_t)3104 * 1024);
        for (int i = gt; i < 28672; i += NGT) p2[i] = z;
    }
    {
        LAS float* scr = (LAS float*)lds + wave * (64 * 33);
        const int gw = lbid() * NWAVES + wave, NGW = G * NWAVES;
        constexpr int NITEMS = 976 + 96 + 64 + 512 + 5632 + 2816 + 1552 + 512;
        for (int it = gw; it < NITEMS; it += NGW) {
            int r = it; const float* W; int N, ldk, mode = 0; bf16* WT;
            if (r < 976) { W = a.in[17]; N = 1952; WT = (bf16*)(ws + WS_W_INAB); ldk = 1024; }
            else if ((r -= 976) < 96) { W = a.in[20]; N = 768; WT = (bf16*)(ws + WS_W_UQ); ldk = 256; }
            else if ((r -= 96) < 64) { W = a.in[21]; N = 1024; WT = (bf16*)(ws + WS_W_UKV); ldk = 256; }
            else if ((r -= 64) < 512) { W = a.in[24]; N = 1024; WT = (bf16*)(ws + WS_W_OUTAB); ldk = 1024; }
            else if ((r -= 512) < 5632) { const int l = r / 2816; r -= l * 2816; W = a.in[15] + (size_t)l * 1024 * 5632; N = 5632; WT = (bf16*)(ws + WS_W_FFI) + (size_t)l * 5632 * 1024; ldk = 1024; mode = 1; }
            else if ((r -= 5632) < 2816) { const int l = r / 1408; r -= l * 1408; W = a.in[16] + (size_t)l * 2816 * 1024; N = 1024; WT = (bf16*)(ws + WS_W_FFO) + (size_t)l * 1024 * 2816; ldk = 2816; }
            else if ((r -= 2816) < 1552) { W = a.in[25]; N = 3104; WT = (bf16*)(ws + WS_W_INC); ldk = 1024; }
            else { r -= 1552; W = a.in[28]; N = 1024; WT = (bf16*)(ws + WS_W_OUTC); ldk = 1024; }
            const int nblk = N / 32, kb = r / nblk, nb = r % nblk, k0 = 64 * kb, n0 = 32 * nb;
            const int drow0 = mode ? ((n0 % 2816) / 128) * 256 + (n0 / 2816) * 128 + (n0 % 128) : n0;
            tr_item(W, N, WT, ldk, k0, n0, drow0, scr, lane);
        }
    }
}

__device__ __forceinline__ void phase_rowwise(const Args& a, int ph) {
    const int tid = ltid(), lane = tid & 63, wave = tid >> 6, G = gridDim.x;
    unsigned char* ws = a.ws;
    const int L = ph >= 10 ? 1 : 0;
    const bool fin = ph == 18, ffn = (ph == 7 || ph == 15);
    const float* g = fin ? a.in[29] : (ffn ? a.in[14] : a.in[13]) + L * 1024;
    const float* MOD = (const float*)(ws + WS_MOD) + (size_t)L * 9 * 6144 + (ffn ? 3072 : 0);
    const float* X = (const float*)(ws + WS_X); bf16* H = (bf16*)(ws + WS_H);
    f32x4 gv[4];
#pragma unroll
    for (int j = 0; j < 4; ++j) gv[j] = *(const f32x4*)(g + 4 * lane + 256 * j);
    for (int m = lbid() * NWAVES + wave; m < MTOK; m += G * NWAVES) {
        const float* xr = ph == 1 ? (m < NPROMPT ? a.in[0] + (size_t)m * 1024 : a.in[1] + (size_t)(m - NPROMPT) * 1024) : X + (size_t)m * 1024;
        f32x4 v[4]; float ss = 0.f;
#pragma unroll
        for (int j = 0; j < 4; ++j) { v[j] = *(const f32x4*)(xr + 4 * lane + 256 * j); ss += (v[j].x * v[j].x + v[j].y * v[j].y) + (v[j].z * v[j].z + v[j].w * v[j].w); }
        const float rstd = rsqrtf(wave_sum(ss) * (1.f / 1024.f) + RMS_EPS);
        if (fin) {
            float* o = a.out + OUT_Y + (size_t)m * 1024;
#pragma unroll
            for (int j = 0; j < 4; ++j) *(f32x4*)(o + 4 * lane + 256 * j) = v[j] * rstd * gv[j];
        } else {
            const int n = m < NPROMPT ? 0 : 1 + ((m - NPROMPT) >> 10);
            const float* sh = MOD + n * 6144; const float* sc = sh + 1024;
#pragma unroll
            for (int j = 0; j < 4; ++j) {
                const f32x4 s4 = *(const f32x4*)(sc + 4 * lane + 256 * j), h4 = *(const f32x4*)(sh + 4 * lane + 256 * j);
                const f32x4 y = v[j] * rstd * gv[j] * (1.f + s4) + h4;
                u32x2 w; w.x = pk2(y.x, y.y); w.y = pk2(y.z, y.w);
                *(u32x2*)(H + (size_t)m * 1024 + 4 * lane + 256 * j) = w;
            }
        }
    }
}
#define XB_TMO      128
#define XB_XCNT(j)  (256  + 64 * (j))
#define XB_XSUB(j)  (1280 + 64 * (j))
#define XB_XGEN(j)  (2304 + 64 * (j))
#define XB_TOP      3328
#define XB_TOPGEN   3392
#define XCD_BAR_WORDS 3456
#define XB_SPIN_CAP (1u << 18)

__device__ __forceinline__ unsigned xb_ld(unsigned* p)              { return __hip_atomic_load(p, __ATOMIC_RELAXED, __HIP_MEMORY_SCOPE_AGENT); }
__device__ __forceinline__ unsigned xb_add(unsigned* p, unsigned v) { return __hip_atomic_fetch_add(p, v, __ATOMIC_RELAXED, __HIP_MEMORY_SCOPE_AGENT); }
__device__ __forceinline__ unsigned xb_xcc_id() { return (unsigned)__builtin_amdgcn_s_getreg((3 << 11) | 20) & 0xFu; }
#define XB_SPIN(cond, bar) do { unsigned _sp = 0; while (cond) { __builtin_amdgcn_s_sleep(1); \
    if ((++_sp & 255u) == 0u) { if (xb_ld(&(bar)[XB_TMO])) break; if (_sp > XB_SPIN_CAP) { atomicAdd(&(bar)[XB_TMO], 1u); break; } } } } while (0)

struct XcdBarrier {
    unsigned* bar; unsigned x;
    volatile LAS unsigned* st;
};

__device__ __forceinline__ XcdBarrier xcd_barrier_post(unsigned* bar, volatile LAS unsigned* st) {
    XcdBarrier b; b.bar = bar; b.x = xb_xcc_id(); b.st = st;
    if (threadIdx.x == 0) (void)xb_add(&bar[XB_XCNT(b.x)], 1u);
    return b;
}
__device__ __forceinline__ void xcd_barrier_complete(unsigned* bar, unsigned x, unsigned& nloc, unsigned& nx) {
    const unsigned G = gridDim.x * gridDim.y * gridDim.z;
    unsigned sum, cnt, mine, sp = 0u;
    for (;;) {
        sum = 0u; cnt = 0u; mine = 0u;
#pragma unroll
        for (unsigned j = 0; j < 16; ++j) { const unsigned c = xb_ld(&bar[XB_XCNT(j)]); sum += c; cnt += (c > 0u) ? 1u : 0u; mine = (j == x) ? c : mine; }
        if (sum == G) break;
        __builtin_amdgcn_s_sleep(1);
        if ((++sp & 255u) == 0u) { if (xb_ld(&bar[XB_TMO])) break; if (sp > XB_SPIN_CAP) { atomicAdd(&bar[XB_TMO], 1u); break; } }
    }
    nloc = mine > 0u ? mine : 1u; nx = cnt > 0u ? cnt : 1u;
}

__device__ __forceinline__ void xcd_barrier(const XcdBarrier& b) {
    asm volatile("s_waitcnt vmcnt(0)" ::: "memory");
    __syncthreads();
    if (threadIdx.x == 0) {
        unsigned* bar = b.bar;
        __builtin_amdgcn_s_waitcnt(0);
        unsigned nloc = b.st[0], nx = b.st[1];
        if (nloc == 0u) { xcd_barrier_complete(bar, b.x, nloc, nx); b.st[0] = nloc; b.st[1] = nx; }
        const unsigned old = xb_add(&bar[XB_XSUB(b.x)], 1u);
        const unsigned gen = old / nloc;
        if (old + 1u == (gen + 1u) * nloc) {
            __builtin_amdgcn_fence(__ATOMIC_RELEASE, "agent");
            asm volatile("s_waitcnt vmcnt(0)" ::: "memory");
            const unsigned og = xb_add(&bar[XB_TOP], 1u);
            const unsigned tg = og / nx;
            if (og + 1u == (tg + 1u) * nx) xb_add(&bar[XB_TOPGEN], 1u);
            else XB_SPIN(xb_ld(&bar[XB_TOPGEN]) == tg, bar);
            __builtin_amdgcn_fence(__ATOMIC_ACQUIRE, "agent");
            xb_add(&bar[XB_XGEN(b.x)], 1u);
            asm volatile("s_waitcnt vmcnt(0)" ::: "memory");
        } else {
            XB_SPIN(xb_ld(&bar[XB_XGEN(b.x)]) == gen, bar);
            __builtin_amdgcn_fence(__ATOMIC_ACQUIRE, "agent");
            asm volatile("s_waitcnt vmcnt(0)" ::: "memory");
        }
    }
    __syncthreads();
}

__device__ __forceinline__ void rope8(u32x4& w, const u32x4 p, const float* cs, bool second) {
    float x[8], y[8];
    x[0] = bflo(w.x); x[1] = bfhi(w.x); x[2] = bflo(w.y); x[3] = bfhi(w.y); x[4] = bflo(w.z); x[5] = bfhi(w.z); x[6] = bflo(w.w); x[7] = bfhi(w.w);
    y[0] = bflo(p.x); y[1] = bfhi(p.x); y[2] = bflo(p.y); y[3] = bfhi(p.y); y[4] = bflo(p.z); y[5] = bfhi(p.z); y[6] = bflo(p.w); y[7] = bfhi(p.w);
    float o[8];
#pragma unroll
    for (int j = 0; j < 8; ++j) { const float c = cs[2 * j], s = cs[2 * j + 1]; o[j] = second ? y[j] * s + x[j] * c : x[j] * c - y[j] * s; }
    w.x = pk2(o[0], o[1]); w.y = pk2(o[2], o[3]); w.z = pk2(o[4], o[5]); w.w = pk2(o[6], o[7]);
}
__device__ __forceinline__ u32x4 shfl_xor4(u32x4 v, int m) { u32x4 r; r.x = __shfl_xor(v.x, m); r.y = __shfl_xor(v.y, m); r.z = __shfl_xor(v.z, m); r.w = __shfl_xor(v.w, m); return r; }
__device__ __forceinline__ void st_f32x8(float* p, u32x4 w) {
    *(f32x4*)p = (f32x4){bflo(w.x), bfhi(w.x), bflo(w.y), bfhi(w.y)}; *(f32x4*)(p + 4) = (f32x4){bflo(w.z), bfhi(w.z), bflo(w.w), bfhi(w.w)};
}

__device__ __forceinline__ void phase_split(const Args& a) {
    const int tid = ltid(), lane = tid & 63, wave = tid >> 6, G = gridDim.x;
    unsigned char* ws = a.ws;
    const bf16* Y = (const bf16*)(ws + WS_Y);
    bf16* CQN = (bf16*)(ws + WS_CQN); bf16* CKVA = (bf16*)(ws + WS_CKVA); bf16* KR = (bf16*)(ws + WS_KR);
    bf16* DQ = (bf16*)(ws + WS_DQ); bf16* DK = (bf16*)(ws + WS_DK); bf16* DV = (bf16*)(ws + WS_DV);
    const float* R8 = (const float*)(ws + WS_ROPE8); const float* R16 = (const float*)(ws + WS_ROPE16);
    const float* gql = a.in[18]; const float* gkv = a.in[19];
    for (int kvrow = lbid() * NWAVES + wave; kvrow < KVROWS; kvrow += G * NWAVES) {
        int m, b, t; bool sample = false, cache = false;
        if (kvrow < NPROMPT) { m = kvrow; b = m >> 8; t = m & 255; }
        else { const int r = kvrow - NPROMPT; b = r / 1280; const int k = r - b * 1280; if (k < 1024) { sample = true; t = k; m = NPROMPT + b * 1024 + k; } else { cache = true; t = k - 1024; m = 0; } }
        *(unsigned*)(CKVA + (size_t)kvrow * 256 + 128 + 2 * lane) = 0u;
        if (cache) {
            const float* s = a.in[2] + (size_t)(b * 256 + t) * 128 + 2 * lane;
            *(unsigned*)(CKVA + (size_t)kvrow * 256 + 2 * lane) = pk2(s[0], s[1]);
            if (lane < 32) KR[(size_t)kvrow * 32 + lane] = (bf16)f2bf(a.in[3][(size_t)(b * 256 + t) * 32 + lane]);
            const int hb = lane >> 4; const size_t so = ((size_t)(b * 4 + hb) * 256 + t) * 128 + (lane & 15) * 8;
            { const f32x4 x0 = *(const f32x4*)(a.in[4] + so), x1 = *(const f32x4*)(a.in[4] + so + 4);
              u32x4 w; w.x = pk2(x0.x, x0.y); w.y = pk2(x0.z, x0.w); w.z = pk2(x1.x, x1.y); w.w = pk2(x1.z, x1.w); *(u32x4*)(DK + (size_t)kvrow * 512 + 8 * lane) = w; }
            { const f32x4 x0 = *(const f32x4*)(a.in[5] + so), x1 = *(const f32x4*)(a.in[5] + so + 4);
              u32x4 w; w.x = pk2(x0.x, x0.y); w.y = pk2(x0.z, x0.w); w.z = pk2(x1.x, x1.y); w.w = pk2(x1.z, x1.w); *(u32x4*)(DV + (size_t)kvrow * 512 + 8 * lane) = w; }
            continue;
        }
        const bf16* yr = Y + (size_t)m * 2048;
        const int grow = t >> 6, gcol = t & 63;
        { const u32x2 w = *(const u32x2*)(yr + 4 * lane); const float x0 = bflo(w.x), x1 = bfhi(w.x), x2 = bflo(w.y), x3 = bfhi(w.y);
          const float rstd = rsqrtf(wave_sum(x0 * x0 + x1 * x1 + x2 * x2 + x3 * x3) * (1.f / 256.f) + RMS_EPS);
          const f32x4 gq = *(const f32x4*)(gql + 4 * lane);
          u32x2 o; o.x = pk2(x0 * rstd * gq.x, x1 * rstd * gq.y); o.y = pk2(x2 * rstd * gq.z, x3 * rstd * gq.w);
          *(u32x2*)(CQN + (size_t)m * 256 + 4 * lane) = o; }
        { const unsigned w = *(const unsigned*)(yr + 256 + 2 * lane); const float x0 = bflo(w), x1 = bfhi(w);
          const float rstd = rsqrtf(wave_sum(x0 * x0 + x1 * x1) * (1.f / 128.f) + RMS_EPS);
          const float y0 = x0 * rstd * gkv[2 * lane], y1 = x1 * rstd * gkv[2 * lane + 1];
          if (!sample) { float* o = a.out + OUT_CKV + (size_t)m * 128 + 2 * lane; o[0] = y0; o[1] = y1; }
          *(unsigned*)(CKVA + (size_t)kvrow * 256 + 2 * lane) = pk2(y0, y1); }
        { float x = lane < 32 ? bf2f(yr[384 + lane]) : 0.f; const float p = __shfl_xor(x, 8);
          if (sample) { const int grp = (lane >> 3) & 3, i = lane & 7; const int pos = grp < 2 ? grow : gcol; const float c = R8[(pos * 8 + i) * 2], s = R8[(pos * 8 + i) * 2 + 1];
              x = (grp & 1) ? p * s + x * c : x * c - p * s; }
          if (lane < 32) { if (!sample) a.out[OUT_KR + (size_t)m * 32 + lane] = x; KR[(size_t)kvrow * 32 + lane] = (bf16)f2bf(x); } }
        const int s8 = lane & 7; const int pos16 = s8 < 4 ? grow : gcol; const int fi0 = (s8 & 1) * 8; const bool second = (s8 & 2) != 0;
        const float* cs = R16 + (pos16 * 16 + fi0) * 2;
        const int hb = lane >> 4; const size_t oo = ((size_t)(b * 4 + hb) * 256 + t) * 128 + (lane & 15) * 8;
        { u32x4 w = *(const u32x4*)(yr + 416 + 8 * lane); const u32x4 p = shfl_xor4(w, 2); if (sample) rope8(w, p, cs, second); *(u32x4*)(DQ + (size_t)m * 512 + 8 * lane) = w; }
        { u32x4 w = *(const u32x4*)(yr + 928 + 8 * lane); const u32x4 p = shfl_xor4(w, 2); if (sample) rope8(w, p, cs, second); else st_f32x8(a.out + OUT_DK + oo, w);
          *(u32x4*)(DK + (size_t)kvrow * 512 + 8 * lane) = w; }
        { const u32x4 w = *(const u32x4*)(yr + 1440 + 8 * lane); if (!sample) st_f32x8(a.out + OUT_DV + oo, w); *(u32x4*)(DV + (size_t)kvrow * 512 + 8 * lane) = w; }
    }
}

template <int D, int DV>
__device__ __forceinline__ void attn_pass(LAS unsigned char* lds, const bf16x8 (&qf)[D / 16], const bf16* kA, int ldA, const bf16* kB, int ldB,
                                          const bf16* vS, int ldV, int nkeys, float csc, f32x16 (&o)[DV / 32]) {
    constexpr int KS = (D + 8) * 2, VS = 144, KP = D / 8, VP = DV / 8;
    LAS unsigned char* Kl = lds; LAS unsigned char* VT = lds + 64 * KS;
    const int tid = ltid(), lane = tid & 63, r32 = lane & 31, hi = lane >> 5;
    const int prow = (r32 & ~12) | (((r32 >> 2) & 1) << 3) | (((r32 >> 3) & 1) << 2);
    const int kkey0 = tid / KP, kdc0 = tid % KP, kkey1 = (tid + 512) / KP, kdc1 = (tid + 512) % KP;
    const bool k2 = (64 * KP > 512) && (tid + 512 < 64 * KP);
    const int vkey0 = lane, vc0 = tid >> 6;
    const bf16* ksrc0 = kdc0 < 8 ? kA + (size_t)kkey0 * ldA + kdc0 * 8 : kB + (size_t)kkey0 * ldB + (kdc0 - 8) * 8;
    const size_t kst0 = kdc0 < 8 ? (size_t)64 * ldA : (size_t)64 * ldB;
    const bf16* ksrc1 = kdc1 < 8 ? kA + (size_t)kkey1 * ldA + kdc1 * 8 : kB + (size_t)kkey1 * ldB + (kdc1 - 8) * 8;
    const size_t kst1 = kdc1 < 8 ? (size_t)64 * ldA : (size_t)64 * ldB;
    const bf16* vsrc0 = vS + (size_t)vkey0 * ldV + vc0 * 8;
    const bf16* vsrc1 = vsrc0 + 64;
    const size_t vst = (size_t)64 * ldV;
    u32x4 kr0, kr1 = {0u, 0u, 0u, 0u}, vr0, vr1 = {0u, 0u, 0u, 0u};
#define ATT_LOAD(t) do { kr0 = *(const u32x4*)(ksrc0 + (t) * kst0); if (k2) kr1 = *(const u32x4*)(ksrc1 + (t) * kst1); \
        vr0 = *(const u32x4*)(vsrc0 + (t) * vst); if (VP == 16) vr1 = *(const u32x4*)(vsrc1 + (t) * vst); } while (0)
#define ATT_VTW(reg, key, c) do { LAS bf16* vt_ = (LAS bf16*)VT + (size_t)((c) * 8) * 72 + (key); \
        vt_[0] = (bf16)(reg.x & 0xffffu); vt_[72] = (bf16)(reg.x >> 16); vt_[144] = (bf16)(reg.y & 0xffffu); vt_[216] = (bf16)(reg.y >> 16); \
        vt_[288] = (bf16)(reg.z & 0xffffu); vt_[360] = (bf16)(reg.z >> 16); vt_[432] = (bf16)(reg.w & 0xffffu); vt_[504] = (bf16)(reg.w >> 16); } while (0)
    float mrun = -1e30f, lsum = 0.f;
#pragma unroll
    for (int i = 0; i < DV / 32; ++i)
#pragma unroll
        for (int r = 0; r < 16; ++r) o[i][r] = 0.f;
    const int NT = nkeys >> 6;
    ATT_LOAD(0);
    for (int t = 0; t < NT; ++t) {
        *(LAS u32x4*)(Kl + kkey0 * KS + kdc0 * 16) = kr0;
        if (k2) *(LAS u32x4*)(Kl + kkey1 * KS + kdc1 * 16) = kr1;
        ATT_VTW(vr0, vkey0, vc0);
        if (VP == 16) ATT_VTW(vr1, vkey0, vc0 + 8);
        __syncthreads();
        if (t + 1 < NT) ATT_LOAD(t + 1);
        f32x16 s0, s1;
#pragma unroll
        for (int r = 0; r < 16; ++r) { s0[r] = 0.f; s1[r] = 0.f; }
#pragma unroll
        for (int dc = 0; dc < D / 16; ++dc) {
            const bf16x8 k0 = *(const LAS bf16x8*)(Kl + prow * KS + (dc * 16 + hi * 8) * 2);
            const bf16x8 k1 = *(const LAS bf16x8*)(Kl + (32 + prow) * KS + (dc * 16 + hi * 8) * 2);
            s0 = mfma32(k0, qf[dc], s0); s1 = mfma32(k1, qf[dc], s1);
        }
        float mx = -1e30f;
#pragma unroll
        for (int r = 0; r < 16; ++r) mx = fmaxf(mx, fmaxf(s0[r], s1[r]));
        mx *= csc; mx = fmaxf(mx, __shfl_xor(mx, 32));
        const float mn = fmaxf(mrun, mx); const float alpha = __builtin_amdgcn_exp2f(mrun - mn); mrun = mn;
        lsum *= alpha;
#pragma unroll
        for (int i = 0; i < DV / 32; ++i)
#pragma unroll
            for (int r = 0; r < 16; ++r) o[i][r] *= alpha;
#pragma unroll
        for (int r = 0; r < 16; ++r) { s0[r] = __builtin_amdgcn_exp2f(s0[r] * csc - mn); s1[r] = __builtin_amdgcn_exp2f(s1[r] * csc - mn); lsum += s0[r] + s1[r]; }
        bf16x8 pf[4];
        pf[0] = pack8(s0[0], s0[1], s0[2], s0[3], s0[4], s0[5], s0[6], s0[7]); pf[1] = pack8(s0[8], s0[9], s0[10], s0[11], s0[12], s0[13], s0[14], s0[15]);
        pf[2] = pack8(s1[0], s1[1], s1[2], s1[3], s1[4], s1[5], s1[6], s1[7]); pf[3] = pack8(s1[8], s1[9], s1[10], s1[11], s1[12], s1[13], s1[14], s1[15]);
#pragma unroll
        for (int dvt = 0; dvt < DV / 32; ++dvt)
#pragma unroll
            for (int kc = 0; kc < 4; ++kc) {
                const bf16x8 v = *(const LAS bf16x8*)(VT + (dvt * 32 + r32) * VS + (16 * kc + 8 * hi) * 2);
                o[dvt] = mfma32(v, pf[kc], o[dvt]);
            }
        __syncthreads();
    }
#undef ATT_LOAD
#undef ATT_VTW
    lsum += __shfl_xor(lsum, 32);
    const float inv = 1.f / lsum;
#pragma unroll
    for (int i = 0; i < DV / 32; ++i)
#pragma unroll
        for (int r = 0; r < 16; ++r) o[i][r] *= inv;
}

__device__ __forceinline__ void attn_mla_unit(const Args& a, LAS unsigned char* lds, bool isS, int b, int h, int qb) {
    unsigned char* ws = a.ws;
    const int tid = ltid(), lane = tid & 63, wave = tid >> 6, r32 = lane & 31, hi = lane >> 5;
    const bf16* QA = (const bf16*)(ws + WS_QA); const bf16* KVA = (const bf16*)(ws + WS_KVA); const bf16* KR = (const bf16*)(ws + WS_KR);
    bf16* MG = (bf16*)(ws + WS_MERGED);
    const int tq = qb * 256 + wave * 32 + r32;
    const int mq = isS ? NPROMPT + b * 1024 + tq : b * 256 + tq;
    const int kvrow0 = isS ? NPROMPT + b * 1280 : b * 256, nkeys = isS ? 1280 : 256;
    const bf16* qp = QA + (size_t)mq * 768 + h * 96;
    bf16x8 qf[6];
#pragma unroll
    for (int dc = 0; dc < 4; ++dc) qf[dc] = *(const bf16x8*)(qp + dc * 16 + hi * 8);
    if (isS) {
        const float* R8 = (const float*)(ws + WS_ROPE8);
#pragma unroll
        for (int dc = 4; dc < 6; ++dc) {
            u32x4 x1 = *(const u32x4*)(qp + dc * 16), x2 = *(const u32x4*)(qp + dc * 16 + 8);
            const int pos = dc == 4 ? (tq >> 6) : (tq & 63);
            if (hi) { u32x4 tmp = x2; rope8(tmp, x1, R8 + pos * 16, true); qf[dc] = __builtin_bit_cast(bf16x8, tmp); }
            else { u32x4 tmp = x1; rope8(tmp, x2, R8 + pos * 16, false); qf[dc] = __builtin_bit_cast(bf16x8, tmp); }
        }
    } else {
        qf[4] = *(const bf16x8*)(qp + 64 + hi * 8); qf[5] = *(const bf16x8*)(qp + 80 + hi * 8);
    }
    f32x16 o[2];
    const float csc = 0.10206207261596575f * 1.4426950408889634f;
    attn_pass<96, 64>(lds, qf, KVA + (size_t)kvrow0 * 1024 + h * 128, 1024, KR + (size_t)kvrow0 * 32, 32, KVA + (size_t)kvrow0 * 1024 + h * 128 + 64, 1024, nkeys, csc, o);
    bf16* op = MG + (size_t)mq * 1024 + h * 64 + 4 * hi;
#pragma unroll
    for (int dvt = 0; dvt < 2; ++dvt)
#pragma unroll
        for (int g = 0; g < 4; ++g) { u32x2 w; w.x = pk2(o[dvt][4 * g], o[dvt][4 * g + 1]); w.y = pk2(o[dvt][4 * g + 2], o[dvt][4 * g + 3]); *(u32x2*)(op + dvt * 32 + g * 8) = w; }
}

__device__ __forceinline__ void attn_diff_unit(const Args& a, LAS unsigned char* lds, bool isS, int b, int hb, int qb, float lam) {
    unsigned char* ws = a.ws;
    const int tid = ltid(), lane = tid & 63, wave = tid >> 6, r32 = lane & 31, hi = lane >> 5;
    const bf16* DQ = (const bf16*)(ws + WS_DQ); const bf16* DK = (const bf16*)(ws + WS_DK); const bf16* DV = (const bf16*)(ws + WS_DV);
    bf16* MG = (bf16*)(ws + WS_MERGED);
    const int tq = qb * 256 + wave * 32 + r32;
    const int mq = isS ? NPROMPT + b * 1024 + tq : b * 256 + tq;
    const int kvrow0 = isS ? NPROMPT + b * 1280 : b * 256, nkeys = isS ? 1280 : 256;
    const float csc = 0.125f * 1.4426950408889634f;
    unsigned o1p[4][8];
    f32x16 o[4];
#pragma unroll 1
    for (int sub = 0; sub < 2; ++sub) {
        const bf16* qp = DQ + (size_t)mq * 512 + hb * 128 + sub * 64;
        bf16x8 qf[4];
#pragma unroll
        for (int dc = 0; dc < 4; ++dc) qf[dc] = *(const bf16x8*)(qp + dc * 16 + hi * 8);
        attn_pass<64, 128>(lds, qf, DK + (size_t)kvrow0 * 512 + hb * 128 + sub * 64, 512, nullptr, 0, DV + (size_t)kvrow0 * 512 + hb * 128, 512, nkeys, csc, o);
        if (sub == 0) {
#pragma unroll
            for (int i = 0; i < 4; ++i)
#pragma unroll
                for (int r = 0; r < 8; ++r) o1p[i][r] = pk2(o[i][2 * r], o[i][2 * r + 1]);
        }
    }
    float ss = 0.f;
#pragma unroll
    for (int i = 0; i < 4; ++i)
#pragma unroll
        for (int r = 0; r < 8; ++r) { const float d0 = bflo(o1p[i][r]) - lam * o[i][2 * r], d1 = bfhi(o1p[i][r]) - lam * o[i][2 * r + 1]; o[i][2 * r] = d0; o[i][2 * r + 1] = d1; ss += d0 * d0 + d1 * d1; }
    ss += __shfl_xor(ss, 32);
    const float rstd = rsqrtf(ss * (1.f / 128.f) + RMS_EPS) * 0.8f;
    const float* gs = a.in[23];
    bf16* op = MG + (size_t)mq * 1024 + 512 + hb * 128 + 4 * hi;
#pragma unroll
    for (int dvt = 0; dvt < 4; ++dvt)
#pragma unroll
        for (int g = 0; g < 4; ++g) {
            const f32x4 gv = *(const f32x4*)(gs + dvt * 32 + g * 8 + 4 * hi);
            u32x2 w; w.x = pk2(o[dvt][4 * g] * rstd * gv.x, o[dvt][4 * g + 1] * rstd * gv.y); w.y = pk2(o[dvt][4 * g + 2] * rstd * gv.z, o[dvt][4 * g + 3] * rstd * gv.w);
            *(u32x2*)(op + dvt * 32 + g * 8) = w;
        }
}

__device__ __forceinline__ void phase_attn(const Args& a, LAS unsigned char* lds) {
    const int lane = ltid() & 63, G = gridDim.x;
    const float* lv = a.in[22];
    const float lam = expf(wave_sum(lv[lane] * lv[64 + lane])) - expf(wave_sum(lv[128 + lane] * lv[192 + lane])) + 0.2f;
    for (int Lx = lbid(); Lx < 1024; Lx += G) {
        const int s = Lx >> 8, i = Lx & 255;
        if (i < 128) {
            if (s == 0) attn_diff_unit(a, lds, true, i >> 4, (i >> 2) & 3, i & 3, lam);
            else if (s == 1) attn_mla_unit(a, lds, false, i >> 3, i & 7, 0);
        } else {
            const int j = i - 128;
            if (s < 2) { const int u = 2 * j + s; attn_mla_unit(a, lds, true, u >> 5, (u >> 2) & 7, u & 3); }
            else if (s == 2) attn_mla_unit(a, lds, false, i >> 3, i & 7, 0);
            else attn_diff_unit(a, lds, false, j >> 2, j & 3, 0, lam);
        }
    }
}

__device__ __forceinline__ void scan_unit(const Args& a, LAS unsigned char* lds, bool isS, int b, int h, int dir) {
    unsigned char* ws = a.ws;
    const int tid = ltid(), lane = tid & 63, wave = tid >> 6, r32 = lane & 31, hi = lane >> 5;
    const bf16* Y2 = (const bf16*)(ws + WS_Y);
    bf16* CP = (bf16*)(a.out + OUT_Y); float* NP = (float*)(ws + WS_NP); float* MP = (float*)(ws + WS_MP);
    const float* bg = a.in[26];
    const int T = isS ? 1024 : 256, nc = isS ? 16 : 4, tok0 = isS ? NPROMPT + b * 1024 : b * 256;
    const int cpbase = isS ? 2048 + ((b * 8 + h) * 2 + dir) * 16 : ((b * 8 + h) * 2 + dir) * 4;
    LAS bf16* kT = (LAS bf16*)lds; LAS bf16* vT = kT + 64 * 72; LAS float* sW = (LAS float*)(vT + 128 * 72); LAS float* sSc = sW + 64;
    const int dt = wave & 1, et = wave >> 1;
    f32x16 C; float nst = 0.f, mst = 0.f;
#pragma unroll
    for (int r = 0; r < 16; ++r) C[r] = 0.f;
    if (isS) {
        const size_t sb = (size_t)((b * 2 + dir) * 8 + h);
        const float* C0 = a.in[6] + sb * 8192;
#pragma unroll
        for (int r = 0; r < 16; ++r) C[r] = C0[(size_t)(32 * dt + (r & 3) + 8 * (r >> 2) + 4 * hi) * 128 + 32 * et + r32];
        nst = a.in[7][sb * 64 + lane]; mst = a.in[8][sb];
    }
    const float bgi = bg[(2 * dir) * 8 + h], bgf = bg[(2 * dir + 1) * 8 + h];
    for (int c = 0; c < nc; ++c) {
        if (wave == 0) {
            const int tok = tok0 + (dir ? T - 1 - (64 * c + lane) : 64 * c + lane);
            const bf16* yr = Y2 + (size_t)tok * 3328 + 3072;
            const float gi = bf2f(yr[(2 * dir) * 8 + h]) + bgi, gf = bf2f(yr[(2 * dir + 1) * 8 + h]) + bgf;
            const float lf = log_sigmoid(gf);
            const float bc = scan_sum(lf, lane); const float g = __shfl(bc, 63);
            const float aa = g - bc + gi; const float amax = wave_max(aa);
            sW[lane] = expf(aa - amax) * 0.125f;
            if (lane == 0) { sSc[0] = g; sSc[1] = amax; }
        }
        __syncthreads();
        const float g = sSc[0], amax = sSc[1];
        {
            const int j = tid >> 3, dc = tid & 7; const int tok = tok0 + (dir ? T - 1 - (64 * c + j) : 64 * c + j);
            const u32x4 kw = *(const u32x4*)(Y2 + (size_t)tok * 3328 + 512 + h * 64 + dc * 8); const float wj = sW[j];
            LAS bf16* kp = kT + (dc * 8) * 72 + j;
            kp[0] = (bf16)f2bf(bflo(kw.x) * wj); kp[72] = (bf16)f2bf(bfhi(kw.x) * wj); kp[144] = (bf16)f2bf(bflo(kw.y) * wj); kp[216] = (bf16)f2bf(bfhi(kw.y) * wj);
            kp[288] = (bf16)f2bf(bflo(kw.z) * wj); kp[360] = (bf16)f2bf(bfhi(kw.z) * wj); kp[432] = (bf16)f2bf(bflo(kw.w) * wj); kp[504] = (bf16)f2bf(bfhi(kw.w) * wj);
#pragma unroll
            for (int q = 0; q < 2; ++q) {
                const int p = tid + q * 512, jv = p >> 4, cc = p & 15; const int tokv = tok0 + (dir ? T - 1 - (64 * c + jv) : 64 * c + jv);
                const u32x4 vw = *(const u32x4*)(Y2 + (size_t)tokv * 3328 + 1024 + h * 128 + cc * 8);
                LAS bf16* vp = vT + (cc * 8) * 72 + jv;
                vp[0] = (bf16)(vw.x & 0xffffu); vp[72] = (bf16)(vw.x >> 16); vp[144] = (bf16)(vw.y & 0xffffu); vp[216] = (bf16)(vw.y >> 16);
                vp[288] = (bf16)(vw.z & 0xffffu); vp[360] = (bf16)(vw.z >> 16); vp[432] = (bf16)(vw.w & 0xffffu); vp[504] = (bf16)(vw.w >> 16);
            }
        }
        __syncthreads();
        f32x16 kv;
#pragma unroll
        for (int r = 0; r < 16; ++r) kv[r] = 0.f;
#pragma unroll
        for (int lc = 0; lc < 4; ++lc) {
            const bf16x8 A = *(const LAS bf16x8*)(kT + (32 * dt + r32) * 72 + 16 * lc + 8 * hi);
            const bf16x8 B = *(const LAS bf16x8*)(vT + (32 * et + r32) * 72 + 16 * lc + 8 * hi);
            kv = mfma32(A, B, kv);
        }
        float kn = 0.f;
        if (wave == 0) {
#pragma unroll
            for (int q = 0; q < 8; ++q) { const u32x4 w = *(const LAS u32x4*)(kT + lane * 72 + q * 8);
                kn += (bflo(w.x) + bfhi(w.x)) + (bflo(w.y) + bfhi(w.y)) + (bflo(w.z) + bfhi(w.z)) + (bflo(w.w) + bfhi(w.w)); }
        }
        const int cpi = cpbase + c;
        bf16* cp = CP + (size_t)cpi * 8192 + (size_t)(32 * et + r32) * 64 + 32 * dt + 4 * hi;
#pragma unroll
        for (int g4 = 0; g4 < 4; ++g4) { u32x2 w; w.x = pk2(C[4 * g4], C[4 * g4 + 1]); w.y = pk2(C[4 * g4 + 2], C[4 * g4 + 3]); *(u32x2*)(cp + 8 * g4) = w; }
        if (wave == 0) { NP[(size_t)cpi * 64 + lane] = nst; if (lane == 0) MP[cpi] = mst; }
        const float mnew = fmaxf(g + mst, amax); const float so = expf(g + mst - mnew), sn = expf(amax - mnew);
#pragma unroll
        for (int r = 0; r < 16; ++r) C[r] = so * C[r] + sn * kv[r];
        nst = so * nst + sn * kn; mst = mnew;
        __syncthreads();
    }
    if (!isS) {
        const size_t sb = (size_t)((b * 2 + dir) * 8 + h);
        float* Co = a.out + OUT_C + sb * 8192;
#pragma unroll
        for (int r = 0; r < 16; ++r) Co[(size_t)(32 * dt + (r & 3) + 8 * (r >> 2) + 4 * hi) * 128 + 32 * et + r32] = C[r];
        if (wave == 0) { a.out[OUT_N + sb * 64 + lane] = nst; if (lane == 0) a.out[OUT_M + sb] = mst; }
    }
}
__device__ __forceinline__ void phase_scan(const Args& a, LAS unsigned char* lds) {
    const int G = gridDim.x;
    for (int Lx = lbid(); Lx < 1024; Lx += G) {
        const int s = Lx >> 8, i = Lx & 255;
        if (i < 128) { if (s == 0) scan_unit(a, lds, true, i >> 4, (i >> 1) & 7, i & 1); }
        else { const int v = (i - 128) * 4 + s; scan_unit(a, lds, false, v >> 4, (v >> 1) & 7, v & 1); }
    }
}

__device__ __forceinline__ void intra_unit(const Args& a, LAS unsigned char* lds, bool isS, int b, int h, int c) {
    unsigned char* ws = a.ws;
    const int tid = ltid(), lane = tid & 63, wave = tid >> 6, r32 = lane & 31, hi = lane >> 5;
    const bf16* Y2 = (const bf16*)(ws + WS_Y);
    const bf16* CP = (const bf16*)(a.out + OUT_Y); const float* NP = (const float*)(ws + WS_NP); const float* MP = (const float*)(ws + WS_MP);
    bf16* HS = (bf16*)(ws + WS_HS);
    const float* bg = a.in[26];
    const int nc = isS ? 16 : 4, tok0 = (isS ? NPROMPT + b * 1024 : b * 256) + 64 * c;
    const int cpb = isS ? 2048 + ((b * 8 + h) * 2) * 16 : ((b * 8 + h) * 2) * 4;
    LAS bf16* sQ = (LAS bf16*)lds; LAS bf16* sK = sQ + 64 * 72; LAS bf16* sVT = sK + 64 * 72;
    LAS float* sB = (LAS float*)(sVT + 128 * 72); LAS float* sU = sB + 128; LAS float* sMT = sU + 128; LAS float* sNP = sMT + 128; LAS float* sMp = sNP + 128; LAS float* sRed = sMp + 2;
    {
        const int l = tid >> 3, dc = tid & 7; const bf16* yr = Y2 + (size_t)(tok0 + l) * 3328 + h * 64 + dc * 8;
        *(LAS u32x4*)(sQ + l * 72 + dc * 8) = *(const u32x4*)yr;
        const u32x4 kw = *(const u32x4*)(yr + 512);
        u32x4 ks; ks.x = pk2(bflo(kw.x) * 0.125f, bfhi(kw.x) * 0.125f); ks.y = pk2(bflo(kw.y) * 0.125f, bfhi(kw.y) * 0.125f);
        ks.z = pk2(bflo(kw.z) * 0.125f, bfhi(kw.z) * 0.125f); ks.w = pk2(bflo(kw.w) * 0.125f, bfhi(kw.w) * 0.125f);
        *(LAS u32x4*)(sK + l * 72 + dc * 8) = ks;
#pragma unroll
        for (int q = 0; q < 2; ++q) {
            const int p = tid + q * 512, lv = p >> 4, cc = p & 15;
            const u32x4 vw = *(const u32x4*)(Y2 + (size_t)(tok0 + lv) * 3328 + 1024 + h * 128 + cc * 8);
            LAS bf16* vp = sVT + (cc * 8) * 72 + lv;
            vp[0] = (bf16)(vw.x & 0xffffu); vp[72] = (bf16)(vw.x >> 16); vp[144] = (bf16)(vw.y & 0xffffu); vp[216] = (bf16)(vw.y >> 16);
            vp[288] = (bf16)(vw.z & 0xffffu); vp[360] = (bf16)(vw.z >> 16); vp[432] = (bf16)(vw.w & 0xffffu); vp[504] = (bf16)(vw.w >> 16);
        }
    }
    if (wave < 2) {
        const int dir = wave; const int l = dir ? 63 - lane : lane;
        const int cpi = cpb + dir * nc + (dir ? nc - 1 - c : c);
        const bf16* yr = Y2 + (size_t)(tok0 + l) * 3328 + 3072;
        const float gi = bf2f(yr[(2 * dir) * 8 + h]) + bg[(2 * dir) * 8 + h], gf = bf2f(yr[(2 * dir + 1) * 8 + h]) + bg[(2 * dir + 1) * 8 + h];
        const float bc = scan_sum(log_sigmoid(gf), lane);
        const float u = gi - bc; const float mx = scan_max(u, lane);
        const float mp = MP[cpi];
        sB[dir * 64 + l] = bc; sU[dir * 64 + l] = u; sMT[dir * 64 + l] = bc + fmaxf(mp, mx);
        sNP[dir * 64 + lane] = NP[(size_t)cpi * 64 + lane];
        if (lane == 0) sMp[dir] = mp;
    }
    __syncthreads();
    const int lt = wave & 1, et = wave >> 1, l = 32 * lt + r32;
    const int prow = (r32 & ~12) | (((r32 >> 2) & 1) << 3) | (((r32 >> 3) & 1) << 2);
    bf16x8 qf[4];
#pragma unroll
    for (int dc = 0; dc < 4; ++dc) qf[dc] = *(const LAS bf16x8*)(sQ + l * 72 + 16 * dc + 8 * hi);
    f32x16 hsum;
#pragma unroll
    for (int r = 0; r < 16; ++r) hsum[r] = 0.f;
#pragma unroll 1
    for (int dir = 0; dir < 2; ++dir) {
        const int cpi = cpb + dir * nc + (dir ? nc - 1 - c : c);
        f32x16 s0, s1, nacc, iacc;
#pragma unroll
        for (int r = 0; r < 16; ++r) { s0[r] = 0.f; s1[r] = 0.f; nacc[r] = 0.f; iacc[r] = 0.f; }
#pragma unroll
        for (int dc = 0; dc < 4; ++dc) {
            const bf16x8 k0 = *(const LAS bf16x8*)(sK + prow * 72 + 16 * dc + 8 * hi);
            const bf16x8 k1 = *(const LAS bf16x8*)(sK + (32 + prow) * 72 + 16 * dc + 8 * hi);
            s0 = mfma32(k0, qf[dc], s0); s1 = mfma32(k1, qf[dc], s1);
        }
        const bf16* cp = CP + (size_t)cpi * 8192 + (size_t)(32 * et + r32) * 64 + 8 * hi;
#pragma unroll
        for (int dc = 0; dc < 4; ++dc) { const bf16x8 cf = *(const bf16x8*)(cp + 16 * dc); iacc = mfma32(cf, qf[dc], iacc); }
        const float bl = sB[dir * 64 + l], mtl = sMT[dir * 64 + l], mp = sMp[dir];
        const float base = bl - mtl;
        float dsum = 0.f;
#pragma unroll
        for (int r = 0; r < 16; ++r) {
            const int si0 = 16 * (r >> 3) + 8 * hi + (r & 7), si1 = 32 + si0;
            const bool ok0 = dir ? (si0 >= l) : (si0 <= l), ok1 = dir ? (si1 >= l) : (si1 <= l);
            const float e0 = __expf(base + sU[dir * 64 + si0]), e1 = __expf(base + sU[dir * 64 + si1]);
            s0[r] = ok0 ? s0[r] * e0 : 0.f; s1[r] = ok1 ? s1[r] * e1 : 0.f; dsum += s0[r] + s1[r];
        }
        bf16x8 pf[4];
        pf[0] = pack8(s0[0], s0[1], s0[2], s0[3], s0[4], s0[5], s0[6], s0[7]); pf[1] = pack8(s0[8], s0[9], s0[10], s0[11], s0[12], s0[13], s0[14], s0[15]);
        pf[2] = pack8(s1[0], s1[1], s1[2], s1[3], s1[4], s1[5], s1[6], s1[7]); pf[3] = pack8(s1[8], s1[9], s1[10], s1[11], s1[12], s1[13], s1[14], s1[15]);
#pragma unroll
        for (int kc = 0; kc < 4; ++kc) { const bf16x8 v = *(const LAS bf16x8*)(sVT + (32 * et + r32) * 72 + 16 * kc + 8 * hi); nacc = mfma32(v, pf[kc], nacc); }
        float qn = 0.f;
#pragma unroll
        for (int q = 0; q < 4; ++q) {
            const u32x4 w = *(const LAS u32x4*)(sQ + l * 72 + 32 * hi + 8 * q); const LAS float* np = sNP + dir * 64 + 32 * hi + 8 * q;
            qn += bflo(w.x) * np[0] + bfhi(w.x) * np[1] + bflo(w.y) * np[2] + bfhi(w.y) * np[3] + bflo(w.z) * np[4] + bfhi(w.z) * np[5] + bflo(w.w) * np[6] + bfhi(w.w) * np[7];
        }
        qn += __shfl_xor(qn, 32); dsum += __shfl_xor(dsum, 32);
        const float inter = expf(bl + mp - mtl);
        const float den = dsum + inter * qn;
        const float inv = 1.f / fmaxf(fabsf(den), expf(-mtl));
#pragma unroll
        for (int r = 0; r < 16; ++r) hsum[r] += (nacc[r] + inter * iacc[r]) * inv;
    }
    float ss = 0.f;
#pragma unroll
    for (int r = 0; r < 16; ++r) ss += hsum[r] * hsum[r];
    ss += __shfl_xor(ss, 32);
    if (hi == 0) sRed[et * 64 + l] = ss;
    __syncthreads();
    const float tot = (sRed[l] + sRed[64 + l]) + (sRed[128 + l] + sRed[192 + l]);
    const float rstd = rsqrtf(tot * (1.f / 128.f) + RMS_EPS);
    const float* gn = a.in[27];
    const bf16* orow = Y2 + (size_t)(tok0 + l) * 3328 + 2048 + h * 128 + 32 * et + 4 * hi;
    bf16* hrow = HS + (size_t)(tok0 + l) * 1024 + h * 128 + 32 * et + 4 * hi;
#pragma unroll
    for (int g4 = 0; g4 < 4; ++g4) {
        const u32x2 ow = *(const u32x2*)(orow + 8 * g4); const f32x4 gv = *(const f32x4*)(gn + 32 * et + 4 * hi + 8 * g4);
        const float o0 = bflo(ow.x), o1 = bfhi(ow.x), o2 = bflo(ow.y), o3 = bfhi(ow.y);
        u32x2 w;
        w.x = pk2(hsum[4 * g4] * rstd * gv.x / (1.f + __expf(-o0)), hsum[4 * g4 + 1] * rstd * gv.y / (1.f + __expf(-o1)));
        w.y = pk2(hsum[4 * g4 + 2] * rstd * gv.z / (1.f + __expf(-o2)), hsum[4 * g4 + 3] * rstd * gv.w / (1.f + __expf(-o3)));
        *(u32x2*)(hrow + 8 * g4) = w;
    }
    __syncthreads();
}
__device__ __forceinline__ void phase_intra(const Args& a, LAS unsigned char* lds) {
    const int G = gridDim.x;
    for (int U = lbid(); U < 2048; U += G) {
        if (U < 1024) intra_unit(a, lds, false, U >> 5, (U >> 2) & 7, U & 3);
        else { const int v = U - 1024; intra_unit(a, lds, true, v >> 7, (v >> 4) & 7, v & 15); }
    }
}

template <int M, int N, int K, class Epi>
__device__ __forceinline__ void run_gemm(LAS unsigned char* lds, const bf16* A, const bf16* Bt, const Epi& E) {
    pg8::Gemm g{A, Bt, M, N, K}; pg8::StaticOrder S; S.init(M, N, (int)gridDim.x, lbid());
    pg8::gemm_phase<Epi, pg8::StaticOrder, true, true>((PG8_LAS unsigned char*)lds, g, S, E);
}
template <int N, int K>
__device__ __forceinline__ void gemm_plain(LAS unsigned char* lds, unsigned char* ws, size_t offA, size_t offB, size_t offO, int dummy) {
    pg8::EpiBf16<0> E{(bf16*)(ws + offO), N, nullptr, 0, 0, 1.f};
    run_gemm<MTOK, N, K>(lds, (const bf16*)(ws + offA), (const bf16*)(ws + offB), E);
}
template <int K>
__device__ __forceinline__ void gemm_gate(const Args& a, LAS unsigned char* lds, unsigned char* ws, size_t offA, size_t offB, bool fromInput, int L, int goff) {
    float* X = (float*)(ws + WS_X);
    EpiGate E{fromInput ? a.in[0] : X, fromInput ? a.in[1] : X + (size_t)NPROMPT * 1024, X, (const float*)(ws + WS_MOD) + (size_t)L * 9 * 6144 + goff};
    run_gemm<MTOK, 1024, K>(lds, (const bf16*)(ws + offA), (const bf16*)(ws + offB), E);
}

__global__ void __launch_bounds__(NTHREADS, 2) fwd_kernel(Args a) {
    extern __shared__ __attribute__((aligned(16))) unsigned char lds_raw[];
    LAS unsigned char* lds = (LAS unsigned char*)lds_raw;
    const int lo = a.ph_lo, hi = a.ph_hi;
    if (threadIdx.x < 16) ((LAS unsigned*)(lds + LDSCTL_OFF))[threadIdx.x] = 0u;
    __syncthreads();
    XcdBarrier bar = xcd_barrier_post((unsigned*)(a.ws + WS_BAR), (volatile LAS unsigned*)(lds + LDSCTL_OFF) + 8);
#define PHASE(k, ...) if (lo <= (k) && (k) < hi) { unsigned char* ws = a.ws; asm volatile("" : "+s"(ws)); __VA_ARGS__; if ((k) + 1 < hi) { if (hi > 1000) cg::this_grid().sync(); else xcd_barrier(bar); } }
    PHASE(0, phase_prep(a, lds))
    PHASE(1, phase_rowwise(a, 1))
    PHASE(2, (gemm_plain<2048, 1024>(lds, ws, WS_H, WS_W_INAB, WS_Y, 0)))
    PHASE(3, phase_split(a))
    PHASE(4, { gemm_plain<768, 256>(lds, ws, WS_CQN, WS_W_UQ, WS_QA, 0);
               pg8::EpiBf16<0> E{(bf16*)(ws + WS_KVA), 1024, nullptr, 0, 0, 1.f};
               run_gemm<KVROWS, 1024, 256>(lds, (const bf16*)(ws + WS_CKVA), (const bf16*)(ws + WS_W_UKV), E); })
    PHASE(5, phase_attn(a, lds))
    PHASE(6, gemm_gate<1024>(a, lds, ws, WS_MERGED, WS_W_OUTAB, true, 0, 2048))
    PHASE(7, phase_rowwise(a, 7))
    PHASE(8, { EpiSwiGLU E{(bf16*)(ws + WS_HID)}; run_gemm<MTOK, 5632, 1024>(lds, (const bf16*)(ws + WS_H), (const bf16*)(ws + WS_W_FFI), E); })
    PHASE(9, gemm_gate<2816>(a, lds, ws, WS_HID, WS_W_FFO, false, 0, 5120))
    PHASE(10, phase_rowwise(a, 10))
    PHASE(11, (gemm_plain<3328, 1024>(lds, ws, WS_H, WS_W_INC, WS_Y, 0)))
    PHASE(12, phase_scan(a, lds))
    PHASE(13, phase_intra(a, lds))
    PHASE(14, gemm_gate<1024>(a, lds, ws, WS_HS, WS_W_OUTC, false, 1, 2048))
    PHASE(15, phase_rowwise(a, 15))
    PHASE(16, { EpiSwiGLU E{(bf16*)(ws + WS_HID)}; run_gemm<MTOK, 5632, 1024>(lds, (const bf16*)(ws + WS_H), (const bf16*)(ws + WS_W_FFI) + (size_t)5632 * 1024, E); })
    PHASE(17, gemm_gate<2816>(a, lds, ws, WS_HID, WS_W_FFO + (size_t)1024 * 2816 * 2, false, 1, 5120))
    PHASE(18, phase_rowwise(a, 18))
#undef PHASE
}

#ifndef MK_COOP
#define MK_COOP 1
#endif
constexpr int NPHASES = 19;
extern "C" void kernel_launch(void* const* d_in, const int* in_sizes, int n_in, void* d_out, int out_size, void* d_ws, size_t ws_size, hipStream_t stream) {
    static int grid = 0;
    if (grid == 0) {
        if (n_in != 30 || ws_size < WS_END) { fprintf(stderr, "kernel_launch: unexpected n_in %d / ws_size %zu\n", n_in, ws_size); grid = -1; return; }
        int dev = 0, cus = 0, per_cu = 0;
        hipGetDevice(&dev); hipDeviceGetAttribute(&cus, hipDeviceAttributeMultiprocessorCount, dev);
        if (hipFuncSetAttribute((const void*)fwd_kernel, hipFuncAttributeMaxDynamicSharedMemorySize, LDS_BYTES) != hipSuccess) { fprintf(stderr, "kernel_launch: hipFuncSetAttribute failed\n"); grid = -1; return; }
        if (hipOccupancyMaxActiveBlocksPerMultiprocessor(&per_cu, (const void*)fwd_kernel, NTHREADS, LDS_BYTES) != hipSuccess || per_cu < 1) per_cu = 1;
        (void)hipGetLastError();
        grid = cus * 1;
    }
    if (grid < 0) return;
    (void)hipMemsetAsync((char*)d_ws + WS_BAR, 0, WS_BAR_BYTES, stream);
    Args a{};
    for (int i = 0; i < 30; ++i) a.in[i] = (const float*)d_in[i];
    a.out = (float*)d_out; a.ws = (unsigned char*)d_ws;
#if MK_COOP
    a.ph_lo = 0; a.ph_hi = NPHASES;
    void* args[] = {&a};
    hipError_t e = hipLaunchCooperativeKernel((const void*)fwd_kernel, dim3(grid), dim3(NTHREADS), args, LDS_BYTES, stream);
    if (e != hipSuccess) fprintf(stderr, "cooperative launch failed: %s (grid %d)\n", hipGetErrorString(e), grid);
#else
    for (int ph = 0; ph < NPHASES; ++ph) {
        a.ph_lo = ph; a.ph_hi = ph + 1;
        hipLaunchKernelGGL(fwd_kernel, dim3(grid), dim3(NTHREADS), LDS_BYTES, stream, a);
    }
#endif
}
```

```cpp
#include <hip/hip_runtime.h>
#include <hip/hip_cooperative_groups.h>
#include <cstdio>
#include <cstdint>
namespace cg = cooperative_groups;
__device__ __forceinline__ int ltid() { int t = threadIdx.x; asm volatile("" : "+v"(t)); return t; }
__device__ __forceinline__ int lbid() { int b = blockIdx.x; asm volatile("" : "+s"(b)); return b; }
#define MK_COOP 1
namespace pg8 {
#define PG8_LAS __attribute__((address_space(3)))
typedef unsigned short bf16_t;
typedef short bf16x8 __attribute__((ext_vector_type(8)));
typedef float f32x4 __attribute__((ext_vector_type(4)));
typedef unsigned u32x4 __attribute__((ext_vector_type(4)));
constexpr int BM = 256, BK = 64, HALF = 128, HTB = HALF * BK * 2  , STAGE_BYTES = 8 * HTB, NXCD = 8, WGM = 8;

__host__ __device__ __forceinline__ int lds_byte(int r, int c) { const int st = (r >> 4) * 2 + (c >> 5), rr = r & 15, cc = c & 31, ob = rr * 64 + cc * 2; return st * 1024 + (ob ^ (((ob >> 9) & 1) << 5)); }
__host__ __device__ __forceinline__ void stage_rc(int b, int& R, int& C) { const int st = b / 1024, sb = b % 1024, swz = sb ^ (((sb >> 9) & 1) << 5); R = (st >> 1) * 16 + swz / 64; C = (st & 1) * 32 + (swz % 64) / 2; }
__host__ __device__ __forceinline__ int perm32(int rho) { const int n = rho >> 4, i = rho & 15; return 8 * (i >> 2) + 4 * n + (i & 3); }

struct Unit { int pm, pn; };
struct Gemm { const bf16_t* A; const bf16_t* Bt; int M, N, K; };

struct StaticOrder {
    int nM, nN, nwg, G, c;
    __host__ __device__ void init(int M, int N, int G_, int c_) { nM = M / BM; nN = N / BM; nwg = nM * nN; G = G_; c = c_; }
    __host__ __device__ bool next(int i, Unit& u) const {
        const long L = (long)i * G + c; if (L >= nwg) return false;
        int wgid = (int)L; { const int q = nwg / NXCD, r = nwg % NXCD, xcd = wgid % NXCD, off = wgid / NXCD; wgid = (xcd < r ? xcd * (q + 1) : r * (q + 1) + (xcd - r) * q) + off; }
        const int nig = WGM * nN, gid = wgid / nig, fm = gid * WGM, gsz = (nM - fm) < WGM ? (nM - fm) : WGM;
        u.pm = fm + ((wgid % nig) % gsz); u.pn = (wgid % nig) / gsz; return true;
    }
    __device__ __forceinline__ void a_ready(const Unit&) const {}
    __device__ __forceinline__ void done(const Unit&) const {}
};

__device__ __forceinline__ unsigned cvt_pk_bf16(float lo, float hi) { unsigned r; asm volatile("v_cvt_pk_bf16_f32 %0, %1, %2" : "=v"(r) : "v"(lo), "v"(hi)); return r; }
typedef float f32x2 __attribute__((ext_vector_type(2)));
__device__ __forceinline__ f32x2 gelu_pk(f32x2 v) {
    const f32x2 av = __builtin_elementwise_abs(v), d = av * 0.2316418882f + 1.0f;
    f32x2 t; t.x = __builtin_amdgcn_rcpf(d.x); t.y = __builtin_amdgcn_rcpf(d.y);
    f32x2 q = t * 0.5307027145f + (-0.7265760135f); q = q * t + 0.7107068705f; q = q * t + (-0.142248368f); q = q * t + 0.127414796f; q = q * t;
    const f32x2 s = (v * v) * (-0.72134752044f);
    f32x2 e; e.x = __builtin_amdgcn_exp2f(s.x); e.y = __builtin_amdgcn_exp2f(s.y);
    const f32x2 m = v * (q * e), r = v - m;
    f32x2 o; o.x = v.x < 0.f ? m.x : r.x; o.y = v.y < 0.f ? m.y : r.y; return o;
}

template <int ACT  > struct EpiBf16 {
    static constexpr bool PERM = true, AFTER_DRAIN = false; static_assert(ACT == 0 || ACT == 1, "EpiBf16: ACT is 0 (none) or 1 (gelu_pk)");
    bf16_t* O; int ldc; const float* bias; int split_cols; size_t split_stride; float scale0;
    __device__ __forceinline__ void operator()(const f32x4 (&acc)[2][2][4][2], const Unit& u, int wr, int wc, int fr, int fq) const {
        const int row0 = u.pm * BM + wr * 64 + fr; int colt = u.pn * BM; bf16_t* base = O;
        float sc = 1.f; if (split_cols) { const int t = colt / split_cols; base += (size_t)t * split_stride; colt -= t * split_cols; if (t == 0) sc = scale0; }
        const int col0 = colt + wc * 32 + 8 * fq, bcol0 = u.pn * BM + wc * 32 + 8 * fq;
        f32x4 bv[2][2];
#pragma unroll
        for (int bj = 0; bj < 2; ++bj)
#pragma unroll
            for (int n = 0; n < 2; ++n) bv[bj][n] = bias ? *(const f32x4*)(bias + bcol0 + bj * HALF + 4 * n) : (f32x4){0.f, 0.f, 0.f, 0.f};
#pragma unroll
        for (int ai = 0; ai < 2; ++ai)
#pragma unroll
            for (int m = 0; m < 4; ++m) { bf16_t* rowp = base + (size_t)(row0 + ai * HALF + m * 16) * ldc + col0;
#pragma unroll
                for (int bj = 0; bj < 2; ++bj) { f32x4 v0 = acc[ai][bj][m][0] + bv[bj][0], v1 = acc[ai][bj][m][1] + bv[bj][1];
                    if (ACT == 1) { f32x2 a = gelu_pk((f32x2){v0[0], v0[1]}), b = gelu_pk((f32x2){v0[2], v0[3]}), c = gelu_pk((f32x2){v1[0], v1[1]}), d = gelu_pk((f32x2){v1[2], v1[3]});
                        v0 = (f32x4){a.x, a.y, b.x, b.y}; v1 = (f32x4){c.x, c.y, d.x, d.y}; }
                    v0 = v0 * sc; v1 = v1 * sc; u32x4 w; w.x = cvt_pk_bf16(v0[0], v0[1]); w.y = cvt_pk_bf16(v0[2], v0[3]); w.z = cvt_pk_bf16(v1[0], v1[1]); w.w = cvt_pk_bf16(v1[2], v1[3]);
                    *(u32x4*)(rowp + bj * HALF) = w; } }
    }
};
template <class Epi, class Sched, bool ALIGN_EPI = false, bool SP2 = false>
__device__ __forceinline__ void gemm_phase(PG8_LAS unsigned char* lds, const Gemm g, const Sched& S, const Epi& E) {
    const int tid = ltid(), wid = __builtin_amdgcn_readfirstlane(tid >> 6), lane = tid & 63, wr = wid >> 2, wc = wid & 3, fr = lane & 15, fq = lane >> 4;
    const int K = g.K, nt = K / BK;
    unsigned voffA[2], voffB[2];
#pragma unroll
    for (int i = 0; i < 2; ++i) { int R, C; stage_rc(tid * 16 + i * 8192, R, C); const int Rb = Epi::PERM ? ((R & ~31) + perm32(R & 31)) : R;
        voffA[i] = (unsigned)(R * K + C) * 2u; voffB[i] = (unsigned)(Rb * K + C) * 2u; }
    const size_t kstep = (size_t)(BK * 2);
    const size_t hstep = (size_t)HALF * K * 2;
    const size_t tstep = 2 * hstep;
    const unsigned ldsw = (unsigned)wid * 1024u;
    const int aoff = lds_byte(wr * 64 + fr, fq * 8), boff = lds_byte(wc * 32 + fr, fq * 8);
#define PG8_SA(b, h) (((b) * 2 + (h)) * HTB)
#define PG8_SB(b, h) ((4 + (b) * 2 + (h)) * HTB)
#define PG8_STAGE(bufoff, gbase, voff) do { _Pragma("unroll") for (int _i = 0; _i < 2; ++_i) \
        __builtin_amdgcn_global_load_lds((const unsigned*)((const char*)(gbase) + (voff)[_i]), (PG8_LAS unsigned*)(lds + (bufoff) + ldsw + _i * 8192), 16, 0, 0); } while (0)
#define PG8_LDA(dst, b, h) do { _Pragma("unroll") for (int m = 0; m < 4; ++m) _Pragma("unroll") for (int k = 0; k < 2; ++k) dst[m][k] = *(const PG8_LAS bf16x8*)(lds + PG8_SA(b, h) + aoff + m * 2048 + k * 1024); } while (0)
#define PG8_LDB(dst, b, h) do { _Pragma("unroll") for (int n = 0; n < 2; ++n) _Pragma("unroll") for (int k = 0; k < 2; ++k) dst[n][k] = *(const PG8_LAS bf16x8*)(lds + PG8_SB(b, h) + boff + n * 2048 + k * 1024); } while (0)
#define PG8_MMA(ai, bj, At, Bt) do { __builtin_amdgcn_s_setprio(1); _Pragma("unroll") for (int m = 0; m < 4; ++m) _Pragma("unroll") for (int n = 0; n < 2; ++n) _Pragma("unroll") for (int k = 0; k < 2; ++k) \
        acc[ai][bj][m][n] = __builtin_amdgcn_mfma_f32_16x16x32_bf16(Bt[n][k], At[m][k], acc[ai][bj][m][n], 0, 0, 0); __builtin_amdgcn_s_setprio(0); } while (0)
#define PG8_WAIT_V(n) asm volatile("s_waitcnt vmcnt(" #n ")" ::: "memory")
#define PG8_WAIT_L(n) asm volatile("s_waitcnt lgkmcnt(" #n ")" ::: "memory")
#define PG8_BAR __builtin_amdgcn_s_barrier()
#define PG8_SCHED __builtin_amdgcn_sched_barrier(0)
    Unit cur, nxt; int ui = 0;
    if (!S.next(0, cur)) return;
    f32x4 acc[2][2][4][2];
#pragma unroll
    for (int a = 0; a < 2; ++a)
#pragma unroll
        for (int b = 0; b < 2; ++b)
#pragma unroll
            for (int m = 0; m < 4; ++m)
#pragma unroll
                for (int n = 0; n < 2; ++n) acc[a][b][m][n] = (f32x4){0.f, 0.f, 0.f, 0.f};
    bf16x8 At[4][2], B0[2][2], B1[2][2];
    const char* cA = (const char*)g.A + (size_t)cur.pm * tstep; const char* cB = (const char*)g.Bt + (size_t)cur.pn * tstep;
    S.a_ready(cur);
    if constexpr (SP2) {
        PG8_STAGE(PG8_SB(0, 0), cB, voffB); PG8_STAGE(PG8_SB(0, 1), cB + hstep, voffB); PG8_STAGE(PG8_SA(0, 0), cA, voffA); PG8_STAGE(PG8_SA(0, 1), cA + hstep, voffA);
        if (wr == 1) PG8_BAR;
        PG8_WAIT_V(2); PG8_BAR;
        PG8_STAGE(PG8_SB(1, 0), cB + kstep, voffB); PG8_STAGE(PG8_SA(1, 0), cA + kstep, voffA); PG8_STAGE(PG8_SB(1, 1), cB + hstep + kstep, voffB);
        PG8_WAIT_V(6); PG8_BAR;
    } else {
        PG8_STAGE(PG8_SB(0, 0), cB, voffB); PG8_STAGE(PG8_SA(0, 0), cA, voffA); PG8_STAGE(PG8_SB(0, 1), cB + hstep, voffB); PG8_STAGE(PG8_SA(0, 1), cA + hstep, voffA);
        if (wr == 1) PG8_BAR;
        PG8_WAIT_V(4); PG8_BAR;
        PG8_STAGE(PG8_SB(1, 0), cB + kstep, voffB); PG8_STAGE(PG8_SA(1, 0), cA + kstep, voffA); PG8_STAGE(PG8_SB(1, 1), cB + hstep + kstep, voffB);
        PG8_WAIT_V(6); PG8_BAR;
    }
    for (;;) {
        const bool has_next = S.next(ui + 1, nxt);
        const char* nA = has_next ? (const char*)g.A + (size_t)nxt.pm * tstep : cA; const char* nB = has_next ? (const char*)g.Bt + (size_t)nxt.pn * tstep : cB;
        for (int t = 0; t < nt; t += 2) {
            const bool last = (t == nt - 2);
            const char* a1 = cA + (size_t)(t + 1) * kstep;
            const char* a2 = last ? nA : cA + (size_t)(t + 2) * kstep; const char* b2 = last ? nB : cB + (size_t)(t + 2) * kstep;
            const char* a3 = a2 + kstep; const char* b3 = b2 + kstep;
            if (last && has_next) S.a_ready(nxt);
            if constexpr (SP2) {
            PG8_LDB(B0, 0, 0); PG8_LDB(B1, 0, 1); PG8_SCHED; PG8_LDA(At, 0, 0); PG8_STAGE(PG8_SA(1, 1), a1 + hstep, voffA);
            PG8_WAIT_V(8); PG8_WAIT_L(0); PG8_BAR; PG8_MMA(0, 0, At, B0); PG8_MMA(0, 1, At, B1); PG8_BAR; PG8_SCHED;
            PG8_LDA(At, 0, 1); PG8_STAGE(PG8_SB(0, 0), b2, voffB); PG8_STAGE(PG8_SB(0, 1), b2 + hstep, voffB); PG8_STAGE(PG8_SA(0, 0), a2, voffA);
            PG8_WAIT_V(8); PG8_WAIT_L(0); PG8_BAR; PG8_MMA(1, 0, At, B0); PG8_MMA(1, 1, At, B1); PG8_BAR; PG8_SCHED;
            PG8_LDB(B0, 1, 0); PG8_LDB(B1, 1, 1); PG8_SCHED; PG8_LDA(At, 1, 0); PG8_STAGE(PG8_SA(0, 1), a2 + hstep, voffA);
            PG8_WAIT_V(8); PG8_WAIT_L(0); PG8_BAR; PG8_MMA(0, 0, At, B0); PG8_MMA(0, 1, At, B1); PG8_BAR; PG8_SCHED;
            PG8_LDA(At, 1, 1); PG8_STAGE(PG8_SB(1, 0), b3, voffB); PG8_STAGE(PG8_SB(1, 1), b3 + hstep, voffB); PG8_STAGE(PG8_SA(1, 0), a3, voffA);
            PG8_WAIT_V(8); PG8_WAIT_L(0); PG8_BAR; PG8_MMA(1, 0, At, B0); PG8_MMA(1, 1, At, B1); PG8_BAR; PG8_SCHED;
            } else {
            PG8_LDB(B0, 0, 0); PG8_SCHED; PG8_LDA(At, 0, 0); PG8_STAGE(PG8_SA(1, 1), a1 + hstep, voffA);
            PG8_WAIT_L(8); PG8_BAR; PG8_WAIT_L(0); PG8_MMA(0, 0, At, B0); PG8_BAR; PG8_SCHED;
            PG8_LDB(B1, 0, 1); PG8_STAGE(PG8_SB(0, 0), b2, voffB);
            PG8_BAR; PG8_WAIT_L(0); PG8_MMA(0, 1, At, B1); PG8_BAR;
            PG8_LDA(At, 0, 1); PG8_STAGE(PG8_SA(0, 0), a2, voffA);
            PG8_BAR; PG8_WAIT_L(0); PG8_MMA(1, 0, At, B0); PG8_BAR; PG8_SCHED;
            PG8_STAGE(PG8_SB(0, 1), b2 + hstep, voffB);
            PG8_WAIT_V(6); PG8_BAR; PG8_MMA(1, 1, At, B1); PG8_BAR;
            PG8_LDB(B0, 1, 0); PG8_SCHED; PG8_LDA(At, 1, 0); PG8_STAGE(PG8_SA(0, 1), a2 + hstep, voffA);
            PG8_WAIT_L(8); PG8_BAR; PG8_WAIT_L(0); PG8_MMA(0, 0, At, B0); PG8_BAR; PG8_SCHED;
            PG8_LDB(B1, 1, 1); PG8_STAGE(PG8_SB(1, 0), b3, voffB);
            PG8_BAR; PG8_WAIT_L(0); PG8_MMA(0, 1, At, B1); PG8_BAR;
            PG8_LDA(At, 1, 1); PG8_STAGE(PG8_SA(1, 0), a3, voffA);
            PG8_BAR; PG8_WAIT_L(0); PG8_MMA(1, 0, At, B0); PG8_BAR; PG8_SCHED;
            PG8_STAGE(PG8_SB(1, 1), b3 + hstep, voffB);
            PG8_WAIT_V(6); PG8_BAR; PG8_MMA(1, 1, At, B1); PG8_BAR;
            }
        }
        if constexpr (ALIGN_EPI) { if (wr == 0) PG8_BAR; }
        if constexpr (!Epi::AFTER_DRAIN) { E(acc, cur, wr, wc, fr, fq); S.done(cur); }
        if (!has_next) break;
#pragma unroll
        for (int a = 0; a < 2; ++a)
#pragma unroll
            for (int b = 0; b < 2; ++b)
#pragma unroll
                for (int m = 0; m < 4; ++m)
#pragma unroll
                    for (int n = 0; n < 2; ++n) acc[a][b][m][n] = (f32x4){0.f, 0.f, 0.f, 0.f};
        cur = nxt; cA = nA; cB = nB; ++ui;
        if constexpr (ALIGN_EPI) { if (wr == 1) PG8_BAR; }
    }
    PG8_WAIT_V(0);
    if constexpr (!ALIGN_EPI) { if (wr == 0) PG8_BAR; }
    PG8_BAR;
    if constexpr (Epi::AFTER_DRAIN) { E.fused(acc, cur, wr, wc, fr, fq, lds, wid, lane); S.done(cur); }
#undef PG8_SA
#undef PG8_SB
#undef PG8_STAGE
#undef PG8_LDA
#undef PG8_LDB
#undef PG8_MMA
#undef PG8_WAIT_V
#undef PG8_WAIT_L
#undef PG8_BAR
#undef PG8_SCHED
}
}

#define LAS __attribute__((address_space(3)))
typedef unsigned short bf16;
typedef short bf16x8 __attribute__((ext_vector_type(8)));
typedef float f32x4 __attribute__((ext_vector_type(4)));
typedef float f32x16 __attribute__((ext_vector_type(16)));
typedef unsigned u32x4 __attribute__((ext_vector_type(4)));
typedef unsigned u32x2 __attribute__((ext_vector_type(2)));

constexpr int NTHREADS = 512, NWAVES = 8;
constexpr int LDS_BYTES = 147456;
constexpr int MTOK = 16384, NPROMPT = 8192, KVROWS = 18432;
constexpr float RMS_EPS = 1e-6f;
constexpr size_t MiB = 1u << 20;
constexpr size_t WS_BAR = 768 * 1024, WS_BAR_BYTES = 16384;
constexpr int LDSCTL_OFF = 131072;
constexpr size_t WS_MOD = 0, WS_ROPE8 = 512 * 1024, WS_ROPE16 = WS_ROPE8 + 4096;
constexpr size_t WS_W_INAB = 1 * MiB, WS_W_UQ = 5 * MiB, WS_W_UKV = 5 * MiB + 512 * 1024, WS_W_OUTAB = 6 * MiB, WS_W_FFI = 8 * MiB, WS_W_FFO = 30 * MiB,
                 WS_W_INC = 41 * MiB, WS_W_OUTC = 48 * MiB;
constexpr size_t WS_X = 50 * MiB;
constexpr size_t WS_CQN = 50 * MiB, WS_CKVA = 58 * MiB, WS_KR = 67 * MiB, WS_DQ = 69 * MiB, WS_DK = 85 * MiB, WS_DV = 103 * MiB;
constexpr size_t WS_H = 114 * MiB, WS_Y = 146 * MiB, WS_QA = 121 * MiB, WS_KVA = 146 * MiB, WS_MERGED = 182 * MiB, WS_HID = 146 * MiB;
constexpr size_t WS_NP = 250 * MiB, WS_MP = 251 * MiB, WS_HS = 114 * MiB, WS_END = 256 * MiB;
constexpr size_t OUT_Y = 0, OUT_CKV = 16777216, OUT_KR = 17825792, OUT_DK = 18087936, OUT_DV = 22282240, OUT_C = 26476544, OUT_N = 30670848, OUT_M = 30703616;

struct Args { const float* in[30]; float* out; unsigned char* ws; int ph_lo, ph_hi; };

__device__ __forceinline__ unsigned f2bf(float f) { unsigned u = __float_as_uint(f); return (u + 0x7fffu + ((u >> 16) & 1u)) >> 16; }
__device__ __forceinline__ unsigned pk2(float lo, float hi) { return pg8::cvt_pk_bf16(lo, hi); }
__device__ __forceinline__ float bflo(unsigned w) { return __uint_as_float(w << 16); }
__device__ __forceinline__ float bfhi(unsigned w) { return __uint_as_float(w & 0xffff0000u); }
__device__ __forceinline__ float bf2f(bf16 b) { return __uint_as_float(((unsigned)b) << 16); }
__device__ __forceinline__ float wave_sum(float v) {
#pragma unroll
    for (int o = 1; o < 64; o <<= 1) v += __shfl_xor(v, o);
    return v;
}
__device__ __forceinline__ float wave_max(float v) {
#pragma unroll
    for (int o = 1; o < 64; o <<= 1) v = fmaxf(v, __shfl_xor(v, o));
    return v;
}
__device__ __forceinline__ float scan_sum(float v, int lane) {
#pragma unroll
    for (int o = 1; o < 64; o <<= 1) { float t = __shfl_up(v, o); if (lane >= o) v += t; }
    return v;
}
__device__ __forceinline__ float scan_max(float v, int lane) {
#pragma unroll
    for (int o = 1; o < 64; o <<= 1) { float t = __shfl_up(v, o); if (lane >= o) v = fmaxf(v, t); }
    return v;
}
__device__ __forceinline__ float log_sigmoid(float x) { return fminf(x, 0.f) - log1pf(expf(-fabsf(x))); }
__device__ __forceinline__ f32x16 mfma32(bf16x8 a, bf16x8 b, f32x16 c) { return __builtin_amdgcn_mfma_f32_32x32x16_bf16(a, b, c, 0, 0, 0); }
__device__ __forceinline__ bf16x8 pack8(float a0, float a1, float a2, float a3, float a4, float a5, float a6, float a7) {
    u32x4 w; w.x = pk2(a0, a1); w.y = pk2(a2, a3); w.z = pk2(a4, a5); w.w = pk2(a6, a7); return __builtin_bit_cast(bf16x8, w);
}

struct EpiGate {
    static constexpr bool PERM = true, AFTER_DRAIN = false;
    const float* baseP; const float* baseS; float* out; const float* mod;
    __device__ __forceinline__ void operator()(const pg8::f32x4 (&acc)[2][2][4][2], const pg8::Unit& u, int wr, int wc, int fr, int fq) const {
        const int rowb = u.pm * 256; const int n = rowb < NPROMPT ? 0 : 1 + ((rowb - NPROMPT) >> 10);
        const int row0 = rowb + wr * 64 + fr, col0 = u.pn * 256 + wc * 32 + 8 * fq;
        const float* gp = mod + n * 6144 + col0;
        f32x4 gv[2][2];
#pragma unroll
        for (int bj = 0; bj < 2; ++bj) { gv[bj][0] = *(const f32x4*)(gp + bj * 128); gv[bj][1] = *(const f32x4*)(gp + bj * 128 + 4); }
        const float* bb = rowb < NPROMPT ? baseP + (size_t)row0 * 1024 : baseS + (size_t)(row0 - NPROMPT) * 1024;
#pragma unroll
        for (int ai = 0; ai < 2; ++ai)
#pragma unroll
            for (int m = 0; m < 4; ++m) {
                const size_t ro = (size_t)(ai * 128 + m * 16) * 1024 + col0;
                float* op = out + (size_t)row0 * 1024 + ro;
#pragma unroll
                for (int bj = 0; bj < 2; ++bj) {
                    const f32x4 x0 = *(const f32x4*)(bb + ro + bj * 128), x1 = *(const f32x4*)(bb + ro + bj * 128 + 4);
                    *(f32x4*)(op + bj * 128) = x0 + gv[bj][0] * acc[ai][bj][m][0];
                    *(f32x4*)(op + bj * 128 + 4) = x1 + gv[bj][1] * acc[ai][bj][m][1];
                }
            }
    }
};
struct EpiSwiGLU {
    static constexpr bool PERM = true, AFTER_DRAIN = false;
    bf16* O;
    __device__ __forceinline__ void operator()(const pg8::f32x4 (&acc)[2][2][4][2], const pg8::Unit& u, int wr, int wc, int fr, int fq) const {
        const int row0 = u.pm * 256 + wr * 64 + fr, col0 = u.pn * 128 + wc * 32 + 8 * fq;
#pragma unroll
        for (int ai = 0; ai < 2; ++ai)
#pragma unroll
            for (int m = 0; m < 4; ++m) {
                float hv[8];
#pragma unroll
                for (int n = 0; n < 2; ++n)
#pragma unroll
                    for (int i = 0; i < 4; ++i) { const float av = acc[ai][0][m][n][i], bv = acc[ai][1][m][n][i]; hv[n * 4 + i] = av * bv * __builtin_amdgcn_rcpf(1.f + __expf(-av)); }
                u32x4 w; w.x = pk2(hv[0], hv[1]); w.y = pk2(hv[2], hv[3]); w.z = pk2(hv[4], hv[5]); w.w = pk2(hv[6], hv[7]);
                *(u32x4*)(O + (size_t)(row0 + ai * 128 + m * 16) * 2816 + col0) = w;
            }
    }
};

__device__ __forceinline__ void tr_item(const float* W, int N, bf16* WT, int ldk, int k0, int n0, int drow0, LAS float* scr, int lane) {
#pragma unroll 8
    for (int i = 0; i < 32; ++i) { const int kk = 2 * i + (lane >> 5); scr[kk * 33 + (lane & 31)] = W[(size_t)(k0 + kk) * N + n0 + (lane & 31)]; }
    __builtin_amdgcn_s_waitcnt(0); asm volatile("" ::: "memory");
    const int c = lane & 7;
#pragma unroll
    for (int j = 0; j < 4; ++j) { const int n = (lane >> 3) + 8 * j; const LAS float* s = scr + (8 * c) * 33 + n;
        u32x4 o; o.x = pk2(s[0 * 33], s[1 * 33]); o.y = pk2(s[2 * 33], s[3 * 33]); o.z = pk2(s[4 * 33], s[5 * 33]); o.w = pk2(s[6 * 33], s[7 * 33]);
        *(u32x4*)(WT + (size_t)(drow0 + n) * ldk + k0 + 8 * c) = o; }
    __builtin_amdgcn_s_waitcnt(0); asm volatile("" ::: "memory");
}

__device__ __forceinline__ void phase_prep(const Args& a, LAS unsigned char* lds) {
    const int tid = ltid(), lane = tid & 63, wave = tid >> 6, G = gridDim.x;
    unsigned char* ws = a.ws;
    float* MOD = (float*)(ws + WS_MOD);
    if (lbid() < 192) {
        LAS float* sS = (LAS float*)lds; LAS float* sRed = sS + 1024 * 12;
        for (int idx = tid; idx < 9 * 1024; idx += NTHREADS) { const int n = idx >> 10, k = idx & 1023; const float c = n == 0 ? a.in[10][k] : a.in[9][(n - 1) * 1024 + k]; sS[k * 12 + n] = c / (1.f + expf(-c)); }
        __syncthreads();
        for (int it = lbid(); it < 192; it += G) {
            const int l = it / 96, j0 = (it % 96) * 64, kg = tid >> 6, jl = tid & 63;
            const float* W = a.in[11] + ((size_t)l * 1024 + kg * 128) * 6144 + j0 + jl;
            float acc[9];
#pragma unroll
            for (int n = 0; n < 9; ++n) acc[n] = 0.f;
#pragma unroll 8
            for (int k = 0; k < 128; ++k) {
                const float w = W[(size_t)k * 6144]; const LAS float* s = sS + (kg * 128 + k) * 12;
                const f32x4 s0 = *(const LAS f32x4*)s, s1 = *(const LAS f32x4*)(s + 4); const float s8 = s[8];
                acc[0] += w * s0.x; acc[1] += w * s0.y; acc[2] += w * s0.z; acc[3] += w * s0.w; acc[4] += w * s1.x; acc[5] += w * s1.y; acc[6] += w * s1.z; acc[7] += w * s1.w; acc[8] += w * s8;
            }
#pragma unroll
            for (int n = 0; n < 9; ++n) sRed[(kg * 64 + jl) * 9 + n] = acc[n];
            __syncthreads();
            for (int idx = tid; idx < 576; idx += NTHREADS) { const int n = idx >> 6, j2 = idx & 63; float s = a.in[12][l * 6144 + j0 + j2];
#pragma unroll
                for (int g = 0; g < 8; ++g) s += sRed[(g * 64 + j2) * 9 + n];
                MOD[(l * 9 + n) * 6144 + j0 + j2] = s; }
            __syncthreads();
        }
    }
    __syncthreads();
    if (lbid() == 0) {
        float* R8 = (float*)(ws + WS_ROPE8); float* R16 = (float*)(ws + WS_ROPE16);
        { const int pos = tid >> 3, i = tid & 7; const float fr = (float)pow(10000.0, -(double)i / 8.0); const float ang = (float)pos * fr; R8[tid * 2] = (float)cos((double)ang); R8[tid * 2 + 1] = (float)sin((double)ang); }
        for (int e = tid; e < 1024; e += NTHREADS) { const int pos = e >> 4, i = e & 15; const float fr = (float)pow(10000.0, -(double)i / 16.0); const float ang = (float)pos * fr; R16[e * 2] = (float)cos((double)ang); R16[e * 2 + 1] = (float)sin((double)ang); }
    }
    {
        const int gt = lbid() * NTHREADS + tid, NGT = G * NTHREADS; const u32x4 z = {0u, 0u, 0u, 0u};
        bf16* wukv = (bf16*)(ws + WS_W_UKV);
        for (int i = gt; i < 1024 * 16; i += NGT) *(u32x4*)(wukv + (size_t)(i >> 4) * 256 + 128 + (i & 15) * 8) = z;
        u32x4* p1 = (u32x4*)((bf16*)(ws + WS_W_INAB) + (size_t)1952 * 1024);
        for (int i = gt; i < 12288; i += NGT) p1[i] = z;
        u32x4* p2 = (u32x4*)((bf16*)(ws + WS_W_INC) + (size_t)3104 * 1024);
        for (int i = gt; i < 28672; i += NGT) p2[i] = z;
    }
    {
        LAS float* scr = (LAS float*)lds + wave * (64 * 33);
        const int gw = lbid() * NWAVES + wave, NGW = G * NWAVES;
        constexpr int NITEMS = 976 + 96 + 64 + 512 + 5632 + 2816 + 1552 + 512;
        for (int it = gw; it < NITEMS; it += NGW) {
            int r = it; const float* W; int N, ldk, mode = 0; bf16* WT;
            if (r < 976) { W = a.in[17]; N = 1952; WT = (bf16*)(ws + WS_W_INAB); ldk = 1024; }
            else if ((r -= 976) < 96) { W = a.in[20]; N = 768; WT = (bf16*)(ws + WS_W_UQ); ldk = 256; }
            else if ((r -= 96) < 64) { W = a.in[21]; N = 1024; WT = (bf16*)(ws + WS_W_UKV); ldk = 256; }
            else if ((r -= 64) < 512) { W = a.in[24]; N = 1024; WT = (bf16*)(ws + WS_W_OUTAB); ldk = 1024; }
            else if ((r -= 512) < 5632) { const int l = r / 2816; r -= l * 2816; W = a.in[15] + (size_t)l * 1024 * 5632; N = 5632; WT = (bf16*)(ws + WS_W_FFI) + (size_t)l * 5632 * 1024; ldk = 1024; mode = 1; }
            else if ((r -= 5632) < 2816) { const int l = r / 1408; r -= l * 1408; W = a.in[16] + (size_t)l * 2816 * 1024; N = 1024; WT = (bf16*)(ws + WS_W_FFO) + (size_t)l * 1024 * 2816; ldk = 2816; }
            else if ((r -= 2816) < 1552) { W = a.in[25]; N = 3104; WT = (bf16*)(ws + WS_W_INC); ldk = 1024; }
            else { r -= 1552; W = a.in[28]; N = 1024; WT = (bf16*)(ws + WS_W_OUTC); ldk = 1024; }
            const int nblk = N / 32, kb = r / nblk, nb = r % nblk, k0 = 64 * kb, n0 = 32 * nb;
            const int drow0 = mode ? ((n0 % 2816) / 128) * 256 + (n0 / 2816) * 128 + (n0 % 128) : n0;
            tr_item(W, N, WT, ldk, k0, n0, drow0, scr, lane);
        }
    }
}

__device__ __forceinline__ void phase_rowwise(const Args& a, int ph) {
    const int tid = ltid(), lane = tid & 63, wave = tid >> 6, G = gridDim.x;
    unsigned char* ws = a.ws;
    const int L = ph >= 10 ? 1 : 0;
    const bool fin = ph == 18, ffn = (ph == 7 || ph == 15);
    const float* g = fin ? a.in[29] : (ffn ? a.in[14] : a.in[13]) + L * 1024;
    const float* MOD = (const float*)(ws + WS_MOD) + (size_t)L * 9 * 6144 + (ffn ? 3072 : 0);
    const float* X = (const float*)(ws + WS_X); bf16* H = (bf16*)(ws + WS_H);
    f32x4 gv[4];
#pragma unroll
    for (int j = 0; j < 4; ++j) gv[j] = *(const f32x4*)(g + 4 * lane + 256 * j);
    for (int m = lbid() * NWAVES + wave; m < MTOK; m += G * NWAVES) {
        const float* xr = ph == 1 ? (m < NPROMPT ? a.in[0] + (size_t)m * 1024 : a.in[1] + (size_t)(m - NPROMPT) * 1024) : X + (size_t)m * 1024;
        f32x4 v[4]; float ss = 0.f;
#pragma unroll
        for (int j = 0; j < 4; ++j) { v[j] = *(const f32x4*)(xr + 4 * lane + 256 * j); ss += (v[j].x * v[j].x + v[j].y * v[j].y) + (v[j].z * v[j].z + v[j].w * v[j].w); }
        const float rstd = rsqrtf(wave_sum(ss) * (1.f / 1024.f) + RMS_EPS);
        if (fin) {
            float* o = a.out + OUT_Y + (size_t)m * 1024;
#pragma unroll
            for (int j = 0; j < 4; ++j) *(f32x4*)(o + 4 * lane + 256 * j) = v[j] * rstd * gv[j];
        } else {
            const int n = m < NPROMPT ? 0 : 1 + ((m - NPROMPT) >> 10);
            const float* sh = MOD + n * 6144; const float* sc = sh + 1024;
#pragma unroll
            for (int j = 0; j < 4; ++j) {
                const f32x4 s4 = *(const f32x4*)(sc + 4 * lane + 256 * j), h4 = *(const f32x4*)(sh + 4 * lane + 256 * j);
                const f32x4 y = v[j] * rstd * gv[j] * (1.f + s4) + h4;
                u32x2 w; w.x = pk2(y.x, y.y); w.y = pk2(y.z, y.w);
                *(u32x2*)(H + (size_t)m * 1024 + 4 * lane + 256 * j) = w;
            }
        }
    }
}
#define XB_TMO      128
#define XB_XCNT(j)  (256  + 64 * (j))
#define XB_XSUB(j)  (1280 + 64 * (j))
#define XB_XGEN(j)  (2304 + 64 * (j))
#define XB_TOP      3328
#define XB_TOPGEN   3392
#define XCD_BAR_WORDS 3456
#define XB_SPIN_CAP (1u << 18)

__device__ __forceinline__ unsigned xb_ld(unsigned* p)              { return __hip_atomic_load(p, __ATOMIC_RELAXED, __HIP_MEMORY_SCOPE_AGENT); }
__device__ __forceinline__ unsigned xb_add(unsigned* p, unsigned v) { return __hip_atomic_fetch_add(p, v, __ATOMIC_RELAXED, __HIP_MEMORY_SCOPE_AGENT); }
__device__ __forceinline__ unsigned xb_xcc_id() { return (unsigned)__builtin_amdgcn_s_getreg((3 << 11) | 20) & 0xFu; }
#define XB_SPIN(cond, bar) do { unsigned _sp = 0; while (cond) { __builtin_amdgcn_s_sleep(1); \
    if ((++_sp & 255u) == 0u) { if (xb_ld(&(bar)[XB_TMO])) break; if (_sp > XB_SPIN_CAP) { atomicAdd(&(bar)[XB_TMO], 1u); break; } } } } while (0)

struct XcdBarrier {
    unsigned* bar; unsigned x;
    volatile LAS unsigned* st;
};

__device__ __forceinline__ XcdBarrier xcd_barrier_post(unsigned* bar, volatile LAS unsigned* st) {
    XcdBarrier b; b.bar = bar; b.x = xb_xcc_id(); b.st = st;
    if (threadIdx.x == 0) (void)xb_add(&bar[XB_XCNT(b.x)], 1u);
    return b;
}
__device__ __forceinline__ void xcd_barrier_complete(unsigned* bar, unsigned x, unsigned& nloc, unsigned& nx) {
    const unsigned G = gridDim.x * gridDim.y * gridDim.z;
    unsigned sum, cnt, mine, sp = 0u;
    for (;;) {
        sum = 0u; cnt = 0u; mine = 0u;
#pragma unroll
        for (unsigned j = 0; j < 16; ++j) { const unsigned c = xb_ld(&bar[XB_XCNT(j)]); sum += c; cnt += (c > 0u) ? 1u : 0u; mine = (j == x) ? c : mine; }
        if (sum == G) break;
        __builtin_amdgcn_s_sleep(1);
        if ((++sp & 255u) == 0u) { if (xb_ld(&bar[XB_TMO])) break; if (sp > XB_SPIN_CAP) { atomicAdd(&bar[XB_TMO], 1u); break; } }
    }
    nloc = mine > 0u ? mine : 1u; nx = cnt > 0u ? cnt : 1u;
}

__device__ __forceinline__ void xcd_barrier(const XcdBarrier& b) {
    asm volatile("s_waitcnt vmcnt(0)" ::: "memory");
    __syncthreads();
    if (threadIdx.x == 0) {
        unsigned* bar = b.bar;
        __builtin_amdgcn_s_waitcnt(0);
        unsigned nloc = b.st[0], nx = b.st[1];
        if (nloc == 0u) { xcd_barrier_complete(bar, b.x, nloc, nx); b.st[0] = nloc; b.st[1] = nx; }
        const unsigned old = xb_add(&bar[XB_XSUB(b.x)], 1u);
        const unsigned gen = old / nloc;
        if (old + 1u == (gen + 1u) * nloc) {
            __builtin_amdgcn_fence(__ATOMIC_RELEASE, "agent");
            asm volatile("s_waitcnt vmcnt(0)" ::: "memory");
            const unsigned og = xb_add(&bar[XB_TOP], 1u);
            const unsigned tg = og / nx;
            if (og + 1u == (tg + 1u) * nx) xb_add(&bar[XB_TOPGEN], 1u);
            else XB_SPIN(xb_ld(&bar[XB_TOPGEN]) == tg, bar);
            __builtin_amdgcn_fence(__ATOMIC_ACQUIRE, "agent");
            xb_add(&bar[XB_XGEN(b.x)], 1u);
            asm volatile("s_waitcnt vmcnt(0)" ::: "memory");
        } else {
            XB_SPIN(xb_ld(&bar[XB_XGEN(b.x)]) == gen, bar);
            __builtin_amdgcn_fence(__ATOMIC_ACQUIRE, "agent");
            asm volatile("s_waitcnt vmcnt(0)" ::: "memory");
        }
    }
    __syncthreads();
}

__device__ __forceinline__ void rope8(u32x4& w, const u32x4 p, const float* cs, bool second) {
    float x[8], y[8];
    x[0] = bflo(w.x); x[1] = bfhi(w.x); x[2] = bflo(w.y); x[3] = bfhi(w.y); x[4] = bflo(w.z); x[5] = bfhi(w.z); x[6] = bflo(w.w); x[7] = bfhi(w.w);
    y[0] = bflo(p.x); y[1] = bfhi(p.x); y[2] = bflo(p.y); y[3] = bfhi(p.y); y[4] = bflo(p.z); y[5] = bfhi(p.z); y[6] = bflo(p.w); y[7] = bfhi(p.w);
    float o[8];
#pragma unroll
    for (int j = 0; j < 8; ++j) { const float c = cs[2 * j], s = cs[2 * j + 1]; o[j] = second ? y[j] * s + x[j] * c : x[j] * c - y[j] * s; }
    w.x = pk2(o[0], o[1]); w.y = pk2(o[2], o[3]); w.z = pk2(o[4], o[5]); w.w = pk2(o[6], o[7]);
}
__device__ __forceinline__ u32x4 shfl_xor4(u32x4 v, int m) { u32x4 r; r.x = __shfl_xor(v.x, m); r.y = __shfl_xor(v.y, m); r.z = __shfl_xor(v.z, m); r.w = __shfl_xor(v.w, m); return r; }
__device__ __forceinline__ void st_f32x8(float* p, u32x4 w) {
    *(f32x4*)p = (f32x4){bflo(w.x), bfhi(w.x), bflo(w.y), bfhi(w.y)}; *(f32x4*)(p + 4) = (f32x4){bflo(w.z), bfhi(w.z), bflo(w.w), bfhi(w.w)};
}

__device__ __forceinline__ void phase_split(const Args& a) {
    const int tid = ltid(), lane = tid & 63, wave = tid >> 6, G = gridDim.x;
    unsigned char* ws = a.ws;
    const bf16* Y = (const bf16*)(ws + WS_Y);
    bf16* CQN = (bf16*)(ws + WS_CQN); bf16* CKVA = (bf16*)(ws + WS_CKVA); bf16* KR = (bf16*)(ws + WS_KR);
    bf16* DQ = (bf16*)(ws + WS_DQ); bf16* DK = (bf16*)(ws + WS_DK); bf16* DV = (bf16*)(ws + WS_DV);
    const float* R8 = (const float*)(ws + WS_ROPE8); const float* R16 = (const float*)(ws + WS_ROPE16);
    const float* gql = a.in[18]; const float* gkv = a.in[19];
    for (int kvrow = lbid() * NWAVES + wave; kvrow < KVROWS; kvrow += G * NWAVES) {
        int m, b, t; bool sample = false, cache = false;
        if (kvrow < NPROMPT) { m = kvrow; b = m >> 8; t = m & 255; }
        else { const int r = kvrow - NPROMPT; b = r / 1280; const int k = r - b * 1280; if (k < 1024) { sample = true; t = k; m = NPROMPT + b * 1024 + k; } else { cache = true; t = k - 1024; m = 0; } }
        *(unsigned*)(CKVA + (size_t)kvrow * 256 + 128 + 2 * lane) = 0u;
        if (cache) {
            const float* s = a.in[2] + (size_t)(b * 256 + t) * 128 + 2 * lane;
            *(unsigned*)(CKVA + (size_t)kvrow * 256 + 2 * lane) = pk2(s[0], s[1]);
            if (lane < 32) KR[(size_t)kvrow * 32 + lane] = (bf16)f2bf(a.in[3][(size_t)(b * 256 + t) * 32 + lane]);
            const int hb = lane >> 4; const size_t so = ((size_t)(b * 4 + hb) * 256 + t) * 128 + (lane & 15) * 8;
            { const f32x4 x0 = *(const f32x4*)(a.in[4] + so), x1 = *(const f32x4*)(a.in[4] + so + 4);
              u32x4 w; w.x = pk2(x0.x, x0.y); w.y = pk2(x0.z, x0.w); w.z = pk2(x1.x, x1.y); w.w = pk2(x1.z, x1.w); *(u32x4*)(DK + (size_t)kvrow * 512 + 8 * lane) = w; }
            { const f32x4 x0 = *(const f32x4*)(a.in[5] + so), x1 = *(const f32x4*)(a.in[5] + so + 4);
              u32x4 w; w.x = pk2(x0.x, x0.y); w.y = pk2(x0.z, x0.w); w.z = pk2(x1.x, x1.y); w.w = pk2(x1.z, x1.w); *(u32x4*)(DV + (size_t)kvrow * 512 + 8 * lane) = w; }
            continue;
        }
        const bf16* yr = Y + (size_t)m * 2048;
        const int grow = t >> 6, gcol = t & 63;
        { const u32x2 w = *(const u32x2*)(yr + 4 * lane); const float x0 = bflo(w.x), x1 = bfhi(w.x), x2 = bflo(w.y), x3 = bfhi(w.y);
          const float rstd = rsqrtf(wave_sum(x0 * x0 + x1 * x1 + x2 * x2 + x3 * x3) * (1.f / 256.f) + RMS_EPS);
          const f32x4 gq = *(const f32x4*)(gql + 4 * lane);
          u32x2 o; o.x = pk2(x0 * rstd * gq.x, x1 * rstd * gq.y); o.y = pk2(x2 * rstd * gq.z, x3 * rstd * gq.w);
          *(u32x2*)(CQN + (size_t)m * 256 + 4 * lane) = o; }
        { const unsigned w = *(const unsigned*)(yr + 256 + 2 * lane); const float x0 = bflo(w), x1 = bfhi(w);
          const float rstd = rsqrtf(wave_sum(x0 * x0 + x1 * x1) * (1.f / 128.f) + RMS_EPS);
          const float y0 = x0 * rstd * gkv[2 * lane], y1 = x1 * rstd * gkv[2 * lane + 1];
          if (!sample) { float* o = a.out + OUT_CKV + (size_t)m * 128 + 2 * lane; o[0] = y0; o[1] = y1; }
          *(unsigned*)(CKVA + (size_t)kvrow * 256 + 2 * lane) = pk2(y0, y1); }
        { float x = lane < 32 ? bf2f(yr[384 + lane]) : 0.f; const float p = __shfl_xor(x, 8);
          if (sample) { const int grp = (lane >> 3) & 3, i = lane & 7; const int pos = grp < 2 ? grow : gcol; const float c = R8[(pos * 8 + i) * 2], s = R8[(pos * 8 + i) * 2 + 1];
              x = (grp & 1) ? p * s + x * c : x * c - p * s; }
          if (lane < 32) { if (!sample) a.out[OUT_KR + (size_t)m * 32 + lane] = x; KR[(size_t)kvrow * 32 + lane] = (bf16)f2bf(x); } }
        const int s8 = lane & 7; const int pos16 = s8 < 4 ? grow : gcol; const int fi0 = (s8 & 1) * 8; const bool second = (s8 & 2) != 0;
        const float* cs = R16 + (pos16 * 16 + fi0) * 2;
        const int hb = lane >> 4; const size_t oo = ((size_t)(b * 4 + hb) * 256 + t) * 128 + (lane & 15) * 8;
        { u32x4 w = *(const u32x4*)(yr + 416 + 8 * lane); const u32x4 p = shfl_xor4(w, 2); if (sample) rope8(w, p, cs, second); *(u32x4*)(DQ + (size_t)m * 512 + 8 * lane) = w; }
        { u32x4 w = *(const u32x4*)(yr + 928 + 8 * lane); const u32x4 p = shfl_xor4(w, 2); if (sample) rope8(w, p, cs, second); else st_f32x8(a.out + OUT_DK + oo, w);
          *(u32x4*)(DK + (size_t)kvrow * 512 + 8 * lane) = w; }
        { const u32x4 w = *(const u32x4*)(yr + 1440 + 8 * lane); if (!sample) st_f32x8(a.out + OUT_DV + oo, w); *(u32x4*)(DV + (size_t)kvrow * 512 + 8 * lane) = w; }
    }
}

template <int D, int DV>
__device__ __forceinline__ void attn_pass(LAS unsigned char* lds, const bf16x8 (&qf)[D / 16], const bf16* kA, int ldA, const bf16* kB, int ldB,
                                          const bf16* vS, int ldV, int nkeys, float csc, f32x16 (&o)[DV / 32]) {
    constexpr int KS = (D + 8) * 2, VS = 144, KP = D / 8, VP = DV / 8;
    LAS unsigned char* Kl = lds; LAS unsigned char* VT = lds + 64 * KS;
    const int tid = ltid(), lane = tid & 63, r32 = lane & 31, hi = lane >> 5;
    const int prow = (r32 & ~12) | (((r32 >> 2) & 1) << 3) | (((r32 >> 3) & 1) << 2);
    const int kkey0 = tid / KP, kdc0 = tid % KP, kkey1 = (tid + 512) / KP, kdc1 = (tid + 512) % KP;
    const bool k2 = (64 * KP > 512) && (tid + 512 < 64 * KP);
    const int vkey0 = lane, vc0 = tid >> 6;
    const bf16* ksrc0 = kdc0 < 8 ? kA + (size_t)kkey0 * ldA + kdc0 * 8 : kB + (size_t)kkey0 * ldB + (kdc0 - 8) * 8;
    const size_t kst0 = kdc0 < 8 ? (size_t)64 * ldA : (size_t)64 * ldB;
    const bf16* ksrc1 = kdc1 < 8 ? kA + (size_t)kkey1 * ldA + kdc1 * 8 : kB + (size_t)kkey1 * ldB + (kdc1 - 8) * 8;
    const size_t kst1 = kdc1 < 8 ? (size_t)64 * ldA : (size_t)64 * ldB;
    const bf16* vsrc0 = vS + (size_t)vkey0 * ldV + vc0 * 8;
    const bf16* vsrc1 = vsrc0 + 64;
    const size_t vst = (size_t)64 * ldV;
    u32x4 kr0, kr1 = {0u, 0u, 0u, 0u}, vr0, vr1 = {0u, 0u, 0u, 0u};
#define ATT_LOAD(t) do { kr0 = *(const u32x4*)(ksrc0 + (t) * kst0); if (k2) kr1 = *(const u32x4*)(ksrc1 + (t) * kst1); \
        vr0 = *(const u32x4*)(vsrc0 + (t) * vst); if (VP == 16) vr1 = *(const u32x4*)(vsrc1 + (t) * vst); } while (0)
#define ATT_VTW(reg, key, c) do { LAS bf16* vt_ = (LAS bf16*)VT + (size_t)((c) * 8) * 72 + (key); \
        vt_[0] = (bf16)(reg.x & 0xffffu); vt_[72] = (bf16)(reg.x >> 16); vt_[144] = (bf16)(reg.y & 0xffffu); vt_[216] = (bf16)(reg.y >> 16); \
        vt_[288] = (bf16)(reg.z & 0xffffu); vt_[360] = (bf16)(reg.z >> 16); vt_[432] = (bf16)(reg.w & 0xffffu); vt_[504] = (bf16)(reg.w >> 16); } while (0)
    float mrun = -1e30f, lsum = 0.f;
#pragma unroll
    for (int i = 0; i < DV / 32; ++i)
#pragma unroll
        for (int r = 0; r < 16; ++r) o[i][r] = 0.f;
    const int NT = nkeys >> 6;
    ATT_LOAD(0);
    for (int t = 0; t < NT; ++t) {
        *(LAS u32x4*)(Kl + kkey0 * KS + kdc0 * 16) = kr0;
        if (k2) *(LAS u32x4*)(Kl + kkey1 * KS + kdc1 * 16) = kr1;
        ATT_VTW(vr0, vkey0, vc0);
        if (VP == 16) ATT_VTW(vr1, vkey0, vc0 + 8);
        __syncthreads();
        if (t + 1 < NT) ATT_LOAD(t + 1);
        f32x16 s0, s1;
#pragma unroll
        for (int r = 0; r < 16; ++r) { s0[r] = 0.f; s1[r] = 0.f; }
#pragma unroll
        for (int dc = 0; dc < D / 16; ++dc) {
            const bf16x8 k0 = *(const LAS bf16x8*)(Kl + prow * KS + (dc * 16 + hi * 8) * 2);
            const bf16x8 k1 = *(const LAS bf16x8*)(Kl + (32 + prow) * KS + (dc * 16 + hi * 8) * 2);
            s0 = mfma32(k0, qf[dc], s0); s1 = mfma32(k1, qf[dc], s1);
        }
        float mx = -1e30f;
#pragma unroll
        for (int r = 0; r < 16; ++r) mx = fmaxf(mx, fmaxf(s0[r], s1[r]));
        mx *= csc; mx = fmaxf(mx, __shfl_xor(mx, 32));
        const float mn = fmaxf(mrun, mx); const float alpha = __builtin_amdgcn_exp2f(mrun - mn); mrun = mn;
        lsum *= alpha;
#pragma unroll
        for (int i = 0; i < DV / 32; ++i)
#pragma unroll
            for (int r = 0; r < 16; ++r) o[i][r] *= alpha;
#pragma unroll
        for (int r = 0; r < 16; ++r) { s0[r] = __builtin_amdgcn_exp2f(s0[r] * csc - mn); s1[r] = __builtin_amdgcn_exp2f(s1[r] * csc - mn); lsum += s0[r] + s1[r]; }
        bf16x8 pf[4];
        pf[0] = pack8(s0[0], s0[1], s0[2], s0[3], s0[4], s0[5], s0[6], s0[7]); pf[1] = pack8(s0[8], s0[9], s0[10], s0[11], s0[12], s0[13], s0[14], s0[15]);
        pf[2] = pack8(s1[0], s1[1], s1[2], s1[3], s1[4], s1[5], s1[6], s1[7]); pf[3] = pack8(s1[8], s1[9], s1[10], s1[11], s1[12], s1[13], s1[14], s1[15]);
#pragma unroll
        for (int dvt = 0; dvt < DV / 32; ++dvt)
#pragma unroll
            for (int kc = 0; kc < 4; ++kc) {
                const bf16x8 v = *(const LAS bf16x8*)(VT + (dvt * 32 + r32) * VS + (16 * kc + 8 * hi) * 2);
                o[dvt] = mfma32(v, pf[kc], o[dvt]);
            }
        __syncthreads();
    }
#undef ATT_LOAD
#undef ATT_VTW
    lsum += __shfl_xor(lsum, 32);
    const float inv = 1.f / lsum;
#pragma unroll
    for (int i = 0; i < DV / 32; ++i)
#pragma unroll
        for (int r = 0; r < 16; ++r) o[i][r] *= inv;
}

__device__ __forceinline__ void attn_mla_unit(const Args& a, LAS unsigned char* lds, bool isS, int b, int h, int qb) {
    unsigned char* ws = a.ws;
    const int tid = ltid(), lane = tid & 63, wave = tid >> 6, r32 = lane & 31, hi = lane >> 5;
    const bf16* QA = (const bf16*)(ws + WS_QA); const bf16* KVA = (const bf16*)(ws + WS_KVA); const bf16* KR = (const bf16*)(ws + WS_KR);
    bf16* MG = (bf16*)(ws + WS_MERGED);
    const int tq = qb * 256 + wave * 32 + r32;
    const int mq = isS ? NPROMPT + b * 1024 + tq : b * 256 + tq;
    const int kvrow0 = isS ? NPROMPT + b * 1280 : b * 256, nkeys = isS ? 1280 : 256;
    const bf16* qp = QA + (size_t)mq * 768 + h * 96;
    bf16x8 qf[6];
#pragma unroll
    for (int dc = 0; dc < 4; ++dc) qf[dc] = *(const bf16x8*)(qp + dc * 16 + hi * 8);
    if (isS) {
        const float* R8 = (const float*)(ws + WS_ROPE8);
#pragma unroll
        for (int dc = 4; dc < 6; ++dc) {
            u32x4 x1 = *(const u32x4*)(qp + dc * 16), x2 = *(const u32x4*)(qp + dc * 16 + 8);
            const int pos = dc == 4 ? (tq >> 6) : (tq & 63);
            if (hi) { u32x4 tmp = x2; rope8(tmp, x1, R8 + pos * 16, true); qf[dc] = __builtin_bit_cast(bf16x8, tmp); }
            else { u32x4 tmp = x1; rope8(tmp, x2, R8 + pos * 16, false); qf[dc] = __builtin_bit_cast(bf16x8, tmp); }
        }
    } else {
        qf[4] = *(const bf16x8*)(qp + 64 + hi * 8); qf[5] = *(const bf16x8*)(qp + 80 + hi * 8);
    }
    f32x16 o[2];
    const float csc = 0.10206207261596575f * 1.4426950408889634f;
    attn_pass<96, 64>(lds, qf, KVA + (size_t)kvrow0 * 1024 + h * 128, 1024, KR + (size_t)kvrow0 * 32, 32, KVA + (size_t)kvrow0 * 1024 + h * 128 + 64, 1024, nkeys, csc, o);
    bf16* op = MG + (size_t)mq * 1024 + h * 64 + 4 * hi;
#pragma unroll
    for (int dvt = 0; dvt < 2; ++dvt)
#pragma unroll
        for (int g = 0; g < 4; ++g) { u32x2 w; w.x = pk2(o[dvt][4 * g], o[dvt][4 * g + 1]); w.y = pk2(o[dvt][4 * g + 2], o[dvt][4 * g + 3]); *(u32x2*)(op + dvt * 32 + g * 8) = w; }
}

__device__ __forceinline__ void attn_diff_unit(const Args& a, LAS unsigned char* lds, bool isS, int b, int hb, int qb, float lam) {
    unsigned char* ws = a.ws;
    const int tid = ltid(), lane = tid & 63, wave = tid >> 6, r32 = lane & 31, hi = lane >> 5;
    const bf16* DQ = (const bf16*)(ws + WS_DQ); const bf16* DK = (const bf16*)(ws + WS_DK); const bf16* DV = (const bf16*)(ws + WS_DV);
    bf16* MG = (bf16*)(ws + WS_MERGED);
    const int tq = qb * 256 + wave * 32 + r32;
    const int mq = isS ? NPROMPT + b * 1024 + tq : b * 256 + tq;
    const int kvrow0 = isS ? NPROMPT + b * 1280 : b * 256, nkeys = isS ? 1280 : 256;
    const float csc = 0.125f * 1.4426950408889634f;
    unsigned o1p[4][8];
    f32x16 o[4];
#pragma unroll 1
    for (int sub = 0; sub < 2; ++sub) {
        const bf16* qp = DQ + (size_t)mq * 512 + hb * 128 + sub * 64;
        bf16x8 qf[4];
#pragma unroll
        for (int dc = 0; dc < 4; ++dc) qf[dc] = *(const bf16x8*)(qp + dc * 16 + hi * 8);
        attn_pass<64, 128>(lds, qf, DK + (size_t)kvrow0 * 512 + hb * 128 + sub * 64, 512, nullptr, 0, DV + (size_t)kvrow0 * 512 + hb * 128, 512, nkeys, csc, o);
        if (sub == 0) {
#pragma unroll
            for (int i = 0; i < 4; ++i)
#pragma unroll
                for (int r = 0; r < 8; ++r) o1p[i][r] = pk2(o[i][2 * r], o[i][2 * r + 1]);
        }
    }
    float ss = 0.f;
#pragma unroll
    for (int i = 0; i < 4; ++i)
#pragma unroll
        for (int r = 0; r < 8; ++r) { const float d0 = bflo(o1p[i][r]) - lam * o[i][2 * r], d1 = bfhi(o1p[i][r]) - lam * o[i][2 * r + 1]; o[i][2 * r] = d0; o[i][2 * r + 1] = d1; ss += d0 * d0 + d1 * d1; }
    ss += __shfl_xor(ss, 32);
    const float rstd = rsqrtf(ss * (1.f / 128.f) + RMS_EPS) * 0.8f;
    const float* gs = a.in[23];
    bf16* op = MG + (size_t)mq * 1024 + 512 + hb * 128 + 4 * hi;
#pragma unroll
    for (int dvt = 0; dvt < 4; ++dvt)
#pragma unroll
        for (int g = 0; g < 4; ++g) {
            const f32x4 gv = *(const f32x4*)(gs + dvt * 32 + g * 8 + 4 * hi);
            u32x2 w; w.x = pk2(o[dvt][4 * g] * rstd * gv.x, o[dvt][4 * g + 1] * rstd * gv.y); w.y = pk2(o[dvt][4 * g + 2] * rstd * gv.z, o[dvt][4 * g + 3] * rstd * gv.w);
            *(u32x2*)(op + dvt * 32 + g * 8) = w;
        }
}

__device__ __forceinline__ void phase_attn(const Args& a, LAS unsigned char* lds) {
    const int lane = ltid() & 63, G = gridDim.x;
    const float* lv = a.in[22];
    const float lam = expf(wave_sum(lv[lane] * lv[64 + lane])) - expf(wave_sum(lv[128 + lane] * lv[192 + lane])) + 0.2f;
    for (int Lx = lbid(); Lx < 1024; Lx += G) {
        const int s = Lx >> 8, i = Lx & 255;
        if (i < 128) {
            if (s == 0) attn_diff_unit(a, lds, true, i >> 4, (i >> 2) & 3, i & 3, lam);
            else if (s == 1) attn_mla_unit(a, lds, false, i >> 3, i & 7, 0);
        } else {
            const int j = i - 128;
            if (s < 2) { const int u = 2 * j + s; attn_mla_unit(a, lds, true, u >> 5, (u >> 2) & 7, u & 3); }
            else if (s == 2) attn_mla_unit(a, lds, false, i >> 3, i & 7, 0);
            else attn_diff_unit(a, lds, false, j >> 2, j & 3, 0, lam);
        }
    }
}

__device__ __forceinline__ void scan_unit(const Args& a, LAS unsigned char* lds, bool isS, int b, int h, int dir) {
    unsigned char* ws = a.ws;
    const int tid = ltid(), lane = tid & 63, wave = tid >> 6, r32 = lane & 31, hi = lane >> 5;
    const bf16* Y2 = (const bf16*)(ws + WS_Y);
    bf16* CP = (bf16*)(a.out + OUT_Y); float* NP = (float*)(ws + WS_NP); float* MP = (float*)(ws + WS_MP);
    const float* bg = a.in[26];
    const int T = isS ? 1024 : 256, nc = isS ? 16 : 4, tok0 = isS ? NPROMPT + b * 1024 : b * 256;
    const int cpbase = isS ? 2048 + ((b * 8 + h) * 2 + dir) * 16 : ((b * 8 + h) * 2 + dir) * 4;
    LAS bf16* kT0 = (LAS bf16*)lds; LAS bf16* vT0 = kT0 + 2 * 64 * 72; LAS float* sW = (LAS float*)(vT0 + 2 * 128 * 72); LAS float* sG = sW + 16 * 64; LAS float* sA = sG + 16;
    const int dt = wave & 1, et = wave >> 1;
    f32x16 C; float nst = 0.f, mst = 0.f;
#pragma unroll
    for (int r = 0; r < 16; ++r) C[r] = 0.f;
    if (isS) {
        const size_t sb = (size_t)((b * 2 + dir) * 8 + h);
        const float* C0 = a.in[6] + sb * 8192;
#pragma unroll
        for (int r = 0; r < 16; ++r) C[r] = C0[(size_t)(32 * dt + (r & 3) + 8 * (r >> 2) + 4 * hi) * 128 + 32 * et + r32];
        nst = a.in[7][sb * 64 + lane]; mst = a.in[8][sb];
    }
    const float bgi = bg[(2 * dir) * 8 + h], bgf = bg[(2 * dir + 1) * 8 + h];
    for (int c = wave; c < nc; c += 8) {
        const int tok = tok0 + (dir ? T - 1 - (64 * c + lane) : 64 * c + lane);
        const bf16* yr = Y2 + (size_t)tok * 3328 + 3072;
        const float gi = bf2f(yr[(2 * dir) * 8 + h]) + bgi, gf = bf2f(yr[(2 * dir + 1) * 8 + h]) + bgf;
        const float bc = scan_sum(log_sigmoid(gf), lane); const float g = __shfl(bc, 63);
        const float aa = g - bc + gi; const float amax = wave_max(aa);
        sW[c * 64 + lane] = expf(aa - amax) * 0.125f;
        if (lane == 0) { sG[c] = g; sA[c] = amax; }
    }
    u32x4 kraw, vraw0, vraw1;
#define SC_LOAD(c) do { const int tk_ = tok0 + (dir ? T - 1 - (64 * (c) + lane) : 64 * (c) + lane); const bf16* yr_ = Y2 + (size_t)tk_ * 3328 + h * 64 + wave * 8; \
        kraw = *(const u32x4*)(yr_ + 512); vraw0 = *(const u32x4*)(yr_ + 1024 + h * 64); vraw1 = *(const u32x4*)(yr_ + 1024 + h * 64 + 64); } while (0)
    SC_LOAD(0);
    __syncthreads();
    for (int c = 0; c < nc; ++c) {
        LAS bf16* kT = kT0 + (c & 1) * (64 * 72); LAS bf16* vT = vT0 + (c & 1) * (128 * 72);
        {
            const float wj = sW[c * 64 + lane];
            LAS bf16* kp = kT + (wave * 8) * 72 + lane;
            kp[0] = (bf16)f2bf(bflo(kraw.x) * wj); kp[72] = (bf16)f2bf(bfhi(kraw.x) * wj); kp[144] = (bf16)f2bf(bflo(kraw.y) * wj); kp[216] = (bf16)f2bf(bfhi(kraw.y) * wj);
            kp[288] = (bf16)f2bf(bflo(kraw.z) * wj); kp[360] = (bf16)f2bf(bfhi(kraw.z) * wj); kp[432] = (bf16)f2bf(bflo(kraw.w) * wj); kp[504] = (bf16)f2bf(bfhi(kraw.w) * wj);
            LAS bf16* vp = vT + (wave * 8) * 72 + lane;
            vp[0] = (bf16)(vraw0.x & 0xffffu); vp[72] = (bf16)(vraw0.x >> 16); vp[144] = (bf16)(vraw0.y & 0xffffu); vp[216] = (bf16)(vraw0.y >> 16);
            vp[288] = (bf16)(vraw0.z & 0xffffu); vp[360] = (bf16)(vraw0.z >> 16); vp[432] = (bf16)(vraw0.w & 0xffffu); vp[504] = (bf16)(vraw0.w >> 16);
            vp += 64 * 72;
            vp[0] = (bf16)(vraw1.x & 0xffffu); vp[72] = (bf16)(vraw1.x >> 16); vp[144] = (bf16)(vraw1.y & 0xffffu); vp[216] = (bf16)(vraw1.y >> 16);
            vp[288] = (bf16)(vraw1.z & 0xffffu); vp[360] = (bf16)(vraw1.z >> 16); vp[432] = (bf16)(vraw1.w & 0xffffu); vp[504] = (bf16)(vraw1.w >> 16);
        }
        __syncthreads();
        if (c + 1 < nc) SC_LOAD(c + 1);
        const float g = sG[c], amax = sA[c];
        f32x16 kv;
#pragma unroll
        for (int r = 0; r < 16; ++r) kv[r] = 0.f;
#pragma unroll
        for (int lc = 0; lc < 4; ++lc) {
            const bf16x8 A = *(const LAS bf16x8*)(kT + (32 * dt + r32) * 72 + 16 * lc + 8 * hi);
            const bf16x8 B = *(const LAS bf16x8*)(vT + (32 * et + r32) * 72 + 16 * lc + 8 * hi);
            kv = mfma32(A, B, kv);
        }
        float kn = 0.f;
        if (wave == 0) {
#pragma unroll
            for (int q = 0; q < 8; ++q) { const u32x4 w = *(const LAS u32x4*)(kT + lane * 72 + q * 8);
                kn += (bflo(w.x) + bfhi(w.x)) + (bflo(w.y) + bfhi(w.y)) + (bflo(w.z) + bfhi(w.z)) + (bflo(w.w) + bfhi(w.w)); }
        }
        const int cpi = cpbase + c;
        bf16* cp = CP + (size_t)cpi * 8192 + (size_t)(32 * et + r32) * 64 + 32 * dt + 4 * hi;
#pragma unroll
        for (int g4 = 0; g4 < 4; ++g4) { u32x2 w; w.x = pk2(C[4 * g4], C[4 * g4 + 1]); w.y = pk2(C[4 * g4 + 2], C[4 * g4 + 3]); *(u32x2*)(cp + 8 * g4) = w; }
        if (wave == 0) { NP[(size_t)cpi * 64 + lane] = nst; if (lane == 0) MP[cpi] = mst; }
        const float mnew = fmaxf(g + mst, amax); const float so = expf(g + mst - mnew), sn = expf(amax - mnew);
#pragma unroll
        for (int r = 0; r < 16; ++r) C[r] = so * C[r] + sn * kv[r];
        nst = so * nst + sn * kn; mst = mnew;
    }
#undef SC_LOAD
    __syncthreads();
    if (!isS) {
        const size_t sb = (size_t)((b * 2 + dir) * 8 + h);
        float* Co = a.out + OUT_C + sb * 8192;
#pragma unroll
        for (int r = 0; r < 16; ++r) Co[(size_t)(32 * dt + (r & 3) + 8 * (r >> 2) + 4 * hi) * 128 + 32 * et + r32] = C[r];
        if (wave == 0) { a.out[OUT_N + sb * 64 + lane] = nst; if (lane == 0) a.out[OUT_M + sb] = mst; }
    }
}
__device__ __forceinline__ void phase_scan(const Args& a, LAS unsigned char* lds) {
    const int G = gridDim.x;
    for (int Lx = lbid(); Lx < 1024; Lx += G) {
        const int s = Lx >> 8, i = Lx & 255;
        if (i < 128) { if (s == 0) scan_unit(a, lds, true, i >> 4, (i >> 1) & 7, i & 1); }
        else { const int v = (i - 128) * 4 + s; scan_unit(a, lds, false, v >> 4, (v >> 1) & 7, v & 1); }
    }
}

__device__ __forceinline__ void phase_intra(const Args& a, LAS unsigned char* lds) {
    unsigned char* ws = a.ws;
    const int tid = ltid(), lane = tid & 63, wave = tid >> 6, r32 = lane & 31, hi = lane >> 5, G = gridDim.x;
    const bf16* Y2 = (const bf16*)(ws + WS_Y);
    const bf16* CP = (const bf16*)(a.out + OUT_Y); const float* NP = (const float*)(ws + WS_NP); const float* MP = (const float*)(ws + WS_MP);
    bf16* HS = (bf16*)(ws + WS_HS);
    const float* bg = a.in[26];
    LAS bf16* sQ = (LAS bf16*)lds; LAS bf16* sK = sQ + 64 * 72; LAS bf16* sVT = sK + 64 * 72;
    LAS float* sB = (LAS float*)(sVT + 128 * 72); LAS float* sU = sB + 128; LAS float* sMT = sU + 128; LAS float* sNP = sMT + 128; LAS float* sMp = sNP + 128; LAS float* sRed = sMp + 2;
    const int lt = wave & 1, et = wave >> 1, l = 32 * lt + r32;
    const int prow = (r32 & ~12) | (((r32 >> 2) & 1) << 3) | (((r32 >> 3) & 1) << 2);
    const int gdir = wave & 1, gl = gdir ? 63 - lane : lane;
    u32x4 qraw, kraw, vraw0, vraw1; float pgi = 0.f, pgf = 0.f, pmp = 0.f, pnp = 0.f;
#define IN_DECODE(U) int tok0, cpb, nc, c, h; do { if ((U) < 1024) { const int b_ = (U) >> 5; h = ((U) >> 2) & 7; c = (U) & 3; nc = 4; tok0 = b_ * 256 + 64 * c; cpb = ((b_ * 8 + h) * 2) * 4; } \
        else { const int v_ = (U) - 1024, b_ = v_ >> 7; h = (v_ >> 4) & 7; c = v_ & 15; nc = 16; tok0 = NPROMPT + b_ * 1024 + 64 * c; cpb = 2048 + ((b_ * 8 + h) * 2) * 16; } } while (0)
#define IN_LOAD() do { const bf16* yr_ = Y2 + (size_t)(tok0 + (tid >> 3)) * 3328 + h * 64 + (tid & 7) * 8; qraw = *(const u32x4*)yr_; kraw = *(const u32x4*)(yr_ + 512); \
        const bf16* yv_ = Y2 + (size_t)(tok0 + lane) * 3328 + 1024 + h * 128 + wave * 8; vraw0 = *(const u32x4*)yv_; vraw1 = *(const u32x4*)(yv_ + 64); \
        if (wave < 2) { const int cpi_ = cpb + gdir * nc + (gdir ? nc - 1 - c : c); const bf16* yg_ = Y2 + (size_t)(tok0 + gl) * 3328 + 3072; \
            pgi = bf2f(yg_[(2 * gdir) * 8 + h]) + bg[(2 * gdir) * 8 + h]; pgf = bf2f(yg_[(2 * gdir + 1) * 8 + h]) + bg[(2 * gdir + 1) * 8 + h]; pmp = MP[cpi_]; pnp = NP[(size_t)cpi_ * 64 + lane]; } } while (0)
    int U = lbid();
    if (U < 2048) { IN_DECODE(U); IN_LOAD(); }
    for (; U < 2048; U += G) {
        int ctok0, ccpb, cnc, cc_, ch;
        { IN_DECODE(U); ctok0 = tok0; ccpb = cpb; cnc = nc; cc_ = c; ch = h; }
        {
            const int ls = tid >> 3, dc = tid & 7;
            *(LAS u32x4*)(sQ + ls * 72 + dc * 8) = qraw;
            u32x4 ks; ks.x = pk2(bflo(kraw.x) * 0.125f, bfhi(kraw.x) * 0.125f); ks.y = pk2(bflo(kraw.y) * 0.125f, bfhi(kraw.y) * 0.125f);
            ks.z = pk2(bflo(kraw.z) * 0.125f, bfhi(kraw.z) * 0.125f); ks.w = pk2(bflo(kraw.w) * 0.125f, bfhi(kraw.w) * 0.125f);
            *(LAS u32x4*)(sK + ls * 72 + dc * 8) = ks;
            LAS bf16* vp = sVT + (wave * 8) * 72 + lane;
            vp[0] = (bf16)(vraw0.x & 0xffffu); vp[72] = (bf16)(vraw0.x >> 16); vp[144] = (bf16)(vraw0.y & 0xffffu); vp[216] = (bf16)(vraw0.y >> 16);
            vp[288] = (bf16)(vraw0.z & 0xffffu); vp[360] = (bf16)(vraw0.z >> 16); vp[432] = (bf16)(vraw0.w & 0xffffu); vp[504] = (bf16)(vraw0.w >> 16);
            vp += 64 * 72;
            vp[0] = (bf16)(vraw1.x & 0xffffu); vp[72] = (bf16)(vraw1.x >> 16); vp[144] = (bf16)(vraw1.y & 0xffffu); vp[216] = (bf16)(vraw1.y >> 16);
            vp[288] = (bf16)(vraw1.z & 0xffffu); vp[360] = (bf16)(vraw1.z >> 16); vp[432] = (bf16)(vraw1.w & 0xffffu); vp[504] = (bf16)(vraw1.w >> 16);
        }
        if (wave < 2) {
            const float bc = scan_sum(log_sigmoid(pgf), lane);
            const float u = pgi - bc; const float mx = scan_max(u, lane);
            sB[gdir * 64 + gl] = bc; sU[gdir * 64 + gl] = u; sMT[gdir * 64 + gl] = bc + fmaxf(pmp, mx);
            sNP[gdir * 64 + lane] = pnp;
            if (lane == 0) sMp[gdir] = pmp;
        }
        __syncthreads();
        if (U + G < 2048) { IN_DECODE(U + G); IN_LOAD(); }
        bf16x8 qf[4];
#pragma unroll
        for (int dc = 0; dc < 4; ++dc) qf[dc] = *(const LAS bf16x8*)(sQ + l * 72 + 16 * dc + 8 * hi);
        f32x16 hsum;
#pragma unroll
        for (int r = 0; r < 16; ++r) hsum[r] = 0.f;
#pragma unroll 1
        for (int dir = 0; dir < 2; ++dir) {
            const int cpi = ccpb + dir * cnc + (dir ? cnc - 1 - cc_ : cc_);
            f32x16 s0, s1, nacc, iacc;
#pragma unroll
            for (int r = 0; r < 16; ++r) { s0[r] = 0.f; s1[r] = 0.f; nacc[r] = 0.f; iacc[r] = 0.f; }
            const bf16* cp = CP + (size_t)cpi * 8192 + (size_t)(32 * et + r32) * 64 + 8 * hi;
            bf16x8 cf[4];
#pragma unroll
            for (int dc = 0; dc < 4; ++dc) cf[dc] = *(const bf16x8*)(cp + 16 * dc);
#pragma unroll
            for (int dc = 0; dc < 4; ++dc) {
                const bf16x8 k0 = *(const LAS bf16x8*)(sK + prow * 72 + 16 * dc + 8 * hi);
                const bf16x8 k1 = *(const LAS bf16x8*)(sK + (32 + prow) * 72 + 16 * dc + 8 * hi);
                s0 = mfma32(k0, qf[dc], s0); s1 = mfma32(k1, qf[dc], s1);
            }
#pragma unroll
            for (int dc = 0; dc < 4; ++dc) iacc = mfma32(cf[dc], qf[dc], iacc);
            const float bl = sB[dir * 64 + l], mtl = sMT[dir * 64 + l], mp = sMp[dir];
            const float base = bl - mtl;
            float dsum = 0.f;
#pragma unroll
            for (int r = 0; r < 16; ++r) {
                const int si0 = 16 * (r >> 3) + 8 * hi + (r & 7), si1 = 32 + si0;
                const bool ok0 = dir ? (si0 >= l) : (si0 <= l), ok1 = dir ? (si1 >= l) : (si1 <= l);
                const float e0 = __expf(base + sU[dir * 64 + si0]), e1 = __expf(base + sU[dir * 64 + si1]);
                s0[r] = ok0 ? s0[r] * e0 : 0.f; s1[r] = ok1 ? s1[r] * e1 : 0.f; dsum += s0[r] + s1[r];
            }
            bf16x8 pf[4];
            pf[0] = pack8(s0[0], s0[1], s0[2], s0[3], s0[4], s0[5], s0[6], s0[7]); pf[1] = pack8(s0[8], s0[9], s0[10], s0[11], s0[12], s0[13], s0[14], s0[15]);
            pf[2] = pack8(s1[0], s1[1], s1[2], s1[3], s1[4], s1[5], s1[6], s1[7]); pf[3] = pack8(s1[8], s1[9], s1[10], s1[11], s1[12], s1[13], s1[14], s1[15]);
#pragma unroll
            for (int kc = 0; kc < 4; ++kc) { const bf16x8 v = *(const LAS bf16x8*)(sVT + (32 * et + r32) * 72 + 16 * kc + 8 * hi); nacc = mfma32(v, pf[kc], nacc); }
            float qn = 0.f;
#pragma unroll
            for (int q = 0; q < 4; ++q) {
                const u32x4 w = *(const LAS u32x4*)(sQ + l * 72 + 32 * hi + 8 * q); const LAS float* np = sNP + dir * 64 + 32 * hi + 8 * q;
                qn += bflo(w.x) * np[0] + bfhi(w.x) * np[1] + bflo(w.y) * np[2] + bfhi(w.y) * np[3] + bflo(w.z) * np[4] + bfhi(w.z) * np[5] + bflo(w.w) * np[6] + bfhi(w.w) * np[7];
            }
            qn += __shfl_xor(qn, 32); dsum += __shfl_xor(dsum, 32);
            const float inter = __expf(bl + mp - mtl);
            const float den = dsum + inter * qn;
            const float inv = 1.f / fmaxf(fabsf(den), __expf(-mtl));
#pragma unroll
            for (int r = 0; r < 16; ++r) hsum[r] += (nacc[r] + inter * iacc[r]) * inv;
        }
        float ss = 0.f;
#pragma unroll
        for (int r = 0; r < 16; ++r) ss += hsum[r] * hsum[r];
        ss += __shfl_xor(ss, 32);
        if (hi == 0) sRed[et * 64 + l] = ss;
        __syncthreads();
        const float tot = (sRed[l] + sRed[64 + l]) + (sRed[128 + l] + sRed[192 + l]);
        const float rstd = rsqrtf(tot * (1.f / 128.f) + RMS_EPS);
        const float* gn = a.in[27];
        const bf16* orow = Y2 + (size_t)(ctok0 + l) * 3328 + 2048 + ch * 128 + 32 * et + 4 * hi;
        bf16* hrow = HS + (size_t)(ctok0 + l) * 1024 + ch * 128 + 32 * et + 4 * hi;
#pragma unroll
        for (int g4 = 0; g4 < 4; ++g4) {
            const u32x2 ow = *(const u32x2*)(orow + 8 * g4); const f32x4 gv = *(const f32x4*)(gn + 32 * et + 4 * hi + 8 * g4);
            const float o0 = bflo(ow.x), o1 = bfhi(ow.x), o2 = bflo(ow.y), o3 = bfhi(ow.y);
            u32x2 w;
            w.x = pk2(hsum[4 * g4] * rstd * gv.x / (1.f + __expf(-o0)), hsum[4 * g4 + 1] * rstd * gv.y / (1.f + __expf(-o1)));
            w.y = pk2(hsum[4 * g4 + 2] * rstd * gv.z / (1.f + __expf(-o2)), hsum[4 * g4 + 3] * rstd * gv.w / (1.f + __expf(-o3)));
            *(u32x2*)(hrow + 8 * g4) = w;
        }
        __syncthreads();
    }
#undef IN_DECODE
#undef IN_LOAD
}

template <int M, int N, int K, class Epi>
__device__ __forceinline__ void run_gemm(LAS unsigned char* lds, const bf16* A, const bf16* Bt, const Epi& E) {
    pg8::Gemm g{A, Bt, M, N, K}; pg8::StaticOrder S; S.init(M, N, (int)gridDim.x, lbid());
    pg8::gemm_phase<Epi, pg8::StaticOrder, true, true>((PG8_LAS unsigned char*)lds, g, S, E);
}
template <int N, int K>
__device__ __forceinline__ void gemm_plain(LAS unsigned char* lds, unsigned char* ws, size_t offA, size_t offB, size_t offO, int dummy) {
    pg8::EpiBf16<0> E{(bf16*)(ws + offO), N, nullptr, 0, 0, 1.f};
    run_gemm<MTOK, N, K>(lds, (const bf16*)(ws + offA), (const bf16*)(ws + offB), E);
}
template <int K>
__device__ __forceinline__ void gemm_gate(const Args& a, LAS unsigned char* lds, unsigned char* ws, size_t offA, size_t offB, bool fromInput, int L, int goff) {
    float* X = (float*)(ws + WS_X);
    EpiGate E{fromInput ? a.in[0] : X, fromInput ? a.in[1] : X + (size_t)NPROMPT * 1024, X, (const float*)(ws + WS_MOD) + (size_t)L * 9 * 6144 + goff};
    run_gemm<MTOK, 1024, K>(lds, (const bf16*)(ws + offA), (const bf16*)(ws + offB), E);
}

__global__ void __launch_bounds__(NTHREADS, 2) fwd_kernel(Args a_in) {
#if defined(__HIP_DEVICE_COMPILE__)
    extern __shared__ __attribute__((aligned(16))) unsigned char lds_raw[];
    LAS unsigned char* lds = (LAS unsigned char*)lds_raw;
    const __attribute__((address_space(4))) Args* kap = (const __attribute__((address_space(4))) Args*)__builtin_amdgcn_kernarg_segment_ptr();
    const int lo = a_in.ph_lo, hi = a_in.ph_hi;
    if (threadIdx.x < 16) ((LAS unsigned*)(lds + LDSCTL_OFF))[threadIdx.x] = 0u;
    __syncthreads();
    XcdBarrier bar = xcd_barrier_post((unsigned*)(a_in.ws + WS_BAR), (volatile LAS unsigned*)(lds + LDSCTL_OFF) + 8);
#define PHASE(k, ...) if (lo <= (k) && (k) < hi) { const __attribute__((address_space(4))) Args* kp_ = kap; asm volatile("" : "+s"(kp_)); const Args a = *kp_; unsigned char* ws = a.ws; __VA_ARGS__; if ((k) + 1 < hi) { if (hi > 1000) cg::this_grid().sync(); else xcd_barrier(bar); } }
    PHASE(0, phase_prep(a, lds))
    PHASE(1, phase_rowwise(a, 1))
    PHASE(2, (gemm_plain<2048, 1024>(lds, ws, WS_H, WS_W_INAB, WS_Y, 0)))
    PHASE(3, phase_split(a))
    PHASE(4, { gemm_plain<768, 256>(lds, ws, WS_CQN, WS_W_UQ, WS_QA, 0);
               pg8::EpiBf16<0> E{(bf16*)(ws + WS_KVA), 1024, nullptr, 0, 0, 1.f};
               run_gemm<KVROWS, 1024, 256>(lds, (const bf16*)(ws + WS_CKVA), (const bf16*)(ws + WS_W_UKV), E); })
    PHASE(5, phase_attn(a, lds))
    PHASE(6, gemm_gate<1024>(a, lds, ws, WS_MERGED, WS_W_OUTAB, true, 0, 2048))
    PHASE(7, phase_rowwise(a, 7))
    PHASE(8, { EpiSwiGLU E{(bf16*)(ws + WS_HID)}; run_gemm<MTOK, 5632, 1024>(lds, (const bf16*)(ws + WS_H), (const bf16*)(ws + WS_W_FFI), E); })
    PHASE(9, gemm_gate<2816>(a, lds, ws, WS_HID, WS_W_FFO, false, 0, 5120))
    PHASE(10, phase_rowwise(a, 10))
    PHASE(11, (gemm_plain<3328, 1024>(lds, ws, WS_H, WS_W_INC, WS_Y, 0)))
    PHASE(12, phase_scan(a, lds))
    PHASE(13, phase_intra(a, lds))
    PHASE(14, gemm_gate<1024>(a, lds, ws, WS_HS, WS_W_OUTC, false, 1, 2048))
    PHASE(15, phase_rowwise(a, 15))
    PHASE(16, { EpiSwiGLU E{(bf16*)(ws + WS_HID)}; run_gemm<MTOK, 5632, 1024>(lds, (const bf16*)(ws + WS_H), (const bf16*)(ws + WS_W_FFI) + (size_t)5632 * 1024, E); })
    PHASE(17, gemm_gate<2816>(a, lds, ws, WS_HID, WS_W_FFO + (size_t)1024 * 2816 * 2, false, 1, 5120))
    PHASE(18, phase_rowwise(a, 18))
#undef PHASE
#endif
}

#ifndef MK_COOP
#define MK_COOP 1
#endif
constexpr int NPHASES = 19;
extern "C" void kernel_launch(void* const* d_in, const int* in_sizes, int n_in, void* d_out, int out_size, void* d_ws, size_t ws_size, hipStream_t stream) {
    static int grid = 0;
    if (grid == 0) {
        if (n_in != 30 || ws_size < WS_END) { fprintf(stderr, "kernel_launch: unexpected n_in %d / ws_size %zu\n", n_in, ws_size); grid = -1; return; }
        int dev = 0, cus = 0, per_cu = 0;
        hipGetDevice(&dev); hipDeviceGetAttribute(&cus, hipDeviceAttributeMultiprocessorCount, dev);
        if (hipFuncSetAttribute((const void*)fwd_kernel, hipFuncAttributeMaxDynamicSharedMemorySize, LDS_BYTES) != hipSuccess) { fprintf(stderr, "kernel_launch: hipFuncSetAttribute failed\n"); grid = -1; return; }
        if (hipOccupancyMaxActiveBlocksPerMultiprocessor(&per_cu, (const void*)fwd_kernel, NTHREADS, LDS_BYTES) != hipSuccess || per_cu < 1) per_cu = 1;
        (void)hipGetLastError();
        grid = cus * 1;
    }
    if (grid < 0) return;
    (void)hipMemsetAsync((char*)d_ws + WS_BAR, 0, WS_BAR_BYTES, stream);
    Args a{};
    for (int i = 0; i < 30; ++i) a.in[i] = (const float*)d_in[i];
    a.out = (float*)d_out; a.ws = (unsigned char*)d_ws;
#if MK_COOP
    a.ph_lo = 0; a.ph_hi = NPHASES;
    void* args[] = {&a};
    hipError_t e = hipLaunchCooperativeKernel((const void*)fwd_kernel, dim3(grid), dim3(NTHREADS), args, LDS_BYTES, stream);
    if (e != hipSuccess) fprintf(stderr, "cooperative launch failed: %s (grid %d)\n", hipGetErrorString(e), grid);
#else
    for (int ph = 0; ph < NPHASES; ++ph) {
        a.ph_lo = ph; a.ph_hi = ph + 1;
        hipLaunchKernelGGL(fwd_kernel, dim3(grid), dim3(NTHREADS), LDS_BYTES, stream, a);
    }
#endif
}
```
